# Optimizing an MI355X kernel written in HIP

```python
import math
import jax, jax.numpy as jnp
from jax import lax
import numpy as np

D_MODEL = 1024
BATCH = 8
SEQ = 8192
DEPTH = 1

MIX_WIDTH = D_MODEL // 2
HG_KEY_DIM = 128
HG_HEADS = MIX_WIDTH // HG_KEY_DIM
HG_VAL_DIM = MIX_WIDTH // HG_HEADS
HG_KEY_WIDTH = HG_HEADS * HG_KEY_DIM
HG_WIDTH = HG_HEADS * HG_VAL_DIM
HG_CHUNK = 64
DIFF_HEAD_DIM = 64
DIFF_HEADS = MIX_WIDTH // (2 * DIFF_HEAD_DIM)
DIFF_QK_WIDTH = DIFF_HEADS * 2 * DIFF_HEAD_DIM
DIFF_V_WIDTH = DIFF_HEADS * 2 * DIFF_HEAD_DIM
Q_BLOCK = 128
IN_WIDTH = 2 * HG_KEY_WIDTH + 2 * HG_WIDTH + 2 * DIFF_QK_WIDTH + 2 * DIFF_V_WIDTH + 2 * D_MODEL
RMS_EPS = 1e-6

kernel_name = "hybrid_hgrn2_diffattn_gated_block"


def rms_norm(x, gain):
    xf = x.astype(jnp.float32)
    xf = xf * lax.rsqrt(jnp.mean(xf * xf, axis=-1, keepdims=True) + RMS_EPS)
    return (xf * gain.astype(jnp.float32)).astype(x.dtype)


def hgrn2_chunked(q, k, v, log_f):
    B, S, H, DK = q.shape
    DV = v.shape[-1]
    N = S // HG_CHUNK

    def to_chunks(t):
        return t.reshape(B, N, HG_CHUNK, H, t.shape[-1]).transpose(1, 0, 3, 2, 4)

    qc, kc, vc, gc = to_chunks(q), to_chunks(k), to_chunks(v), to_chunks(log_f)
    bc = jnp.cumsum(gc, axis=3)
    causal = jnp.tril(jnp.ones((HG_CHUNK, HG_CHUNK), dtype=bool))[:, :, None]

    def step(state, inp):
        qt, kt, vt, bt = inp
        o_inter = jnp.einsum('bhtd,bhde->bhte', qt * jnp.exp(bt), state)
        rel = bt[:, :, :, None, :] - bt[:, :, None, :, :]
        decay = jnp.exp(jnp.where(causal, rel, -jnp.inf))
        scores = jnp.einsum('bhtd,bhtsd,bhsd->bhts', qt, decay, kt)
        o = o_inter + jnp.einsum('bhts,bhse->bhte', scores, vt)
        b_last = bt[:, :, -1:, :]
        state = (jnp.exp(b_last[:, :, 0, :])[..., None] * state
                 + jnp.einsum('bhsd,bhse->bhde', kt * jnp.exp(b_last - bt), vt))
        return state, o

    state0 = jnp.zeros((B, H, DK, DV), jnp.float32)
    _, o = lax.scan(step, state0, (qc, kc, vc, bc))
    return o.transpose(1, 0, 3, 2, 4).reshape(B, S, H, DV)


def diff_attention(q, k, v, lam):
    B, S, H, _, DH = q.shape
    NB = S // Q_BLOCK
    qb = (q.astype(jnp.float32) * (DH ** -0.5)).reshape(B, NB, Q_BLOCK, H, 2, DH).transpose(1, 0, 3, 4, 2, 5)
    kt = k.astype(jnp.float32).transpose(0, 2, 3, 1, 4)
    vt = v.astype(jnp.float32).transpose(0, 2, 1, 3)
    kpos = jnp.arange(S)

    def one_block(args):
        q_blk, blk = args
        s = jnp.einsum('bhjqd,bhjkd->bhjqk', q_blk, kt)
        qpos = blk * Q_BLOCK + jnp.arange(Q_BLOCK)
        mask = kpos[None, :] <= qpos[:, None]
        p = jax.nn.softmax(jnp.where(mask, s, -jnp.inf), axis=-1)
        a = p[:, :, 0] - lam * p[:, :, 1]
        return jnp.einsum('bhqk,bhke->bhqe', a, vt)

    o = lax.map(one_block, (qb, jnp.arange(NB)))
    return o.transpose(1, 0, 3, 2, 4).reshape(B, S, H, 2 * DH)


def setup_inputs(seed: int = 0) -> dict:
    key = jax.random.key(seed)
    ks = jax.random.split(key, 20)
    f32 = jnp.float32
    n = lambda k, shape, s: jax.random.normal(k, shape, f32) * s
    return {
        "x": n(ks[0], (BATCH, SEQ, D_MODEL), 1.0),
        "c": n(ks[1], (BATCH, D_MODEL), 1.0),
        "w_ada": n(ks[2], (DEPTH, D_MODEL, 3 * D_MODEL), D_MODEL ** -0.5),
        "b_ada": n(ks[3], (DEPTH, 3 * D_MODEL), 0.01),
        "g_pre": 1.0 + n(ks[4], (DEPTH, D_MODEL), 0.02),
        "g_post": 1.0 + n(ks[5], (DEPTH, D_MODEL), 0.02),
        "w_in": n(ks[6], (DEPTH, D_MODEL, IN_WIDTH), D_MODEL ** -0.5),
        "lb_logits": n(ks[7], (DEPTH + 1, HG_KEY_WIDTH), 0.5),
        "hg_norm_gain": 1.0 + n(ks[8], (DEPTH, HG_WIDTH), 0.02),
        "lambda_q1": n(ks[9], (DEPTH, DIFF_HEAD_DIM), 0.1),
        "lambda_k1": n(ks[10], (DEPTH, DIFF_HEAD_DIM), 0.1),
        "lambda_q2": n(ks[11], (DEPTH, DIFF_HEAD_DIM), 0.1),
        "lambda_k2": n(ks[12], (DEPTH, DIFF_HEAD_DIM), 0.1),
        "diff_norm_gain": 1.0 + n(ks[13], (DEPTH, DIFF_V_WIDTH), 0.02),
        "w_branch_a": n(ks[14], (DEPTH, HG_WIDTH, D_MODEL), HG_WIDTH ** -0.5),
        "w_branch_b": n(ks[15], (DEPTH, DIFF_V_WIDTH, D_MODEL), DIFF_V_WIDTH ** -0.5),
        "w_out": n(ks[16], (DEPTH, D_MODEL, D_MODEL), D_MODEL ** -0.5),
    }


def reference(x, c, w_ada, b_ada, g_pre, g_post, w_in, lb_logits, hg_norm_gain,
              lambda_q1, lambda_k1, lambda_q2, lambda_k2, diff_norm_gain,
              w_branch_a, w_branch_b, w_out):
    B, S, _ = x.shape
    f32 = jnp.float32
    split_sizes = [HG_KEY_WIDTH, HG_KEY_WIDTH, HG_WIDTH, HG_WIDTH,
                   DIFF_QK_WIDTH, DIFF_QK_WIDTH, DIFF_V_WIDTH, DIFF_V_WIDTH,
                   D_MODEL, D_MODEL]
    split_idx = [int(v) for v in np.cumsum(split_sizes)[:-1]]
    lb_all = jnp.cumsum(jax.nn.softmax(lb_logits.astype(f32), axis=0), axis=0)

    for l in range(DEPTH):
        mod = jax.nn.silu(c) @ w_ada[l] + b_ada[l]
        shift, scale, gate = jnp.split(mod, 3, axis=-1)
        h = rms_norm(x, g_pre[l]) * (1.0 + scale[:, None, :]) + shift[:, None, :]

        proj = h @ w_in[l]
        hq, hf, hi, hg, dq, dk, dv, dg, ma, mb = jnp.split(proj, split_idx, axis=-1)

        lb = lb_all[l].reshape(HG_HEADS, HG_KEY_DIM)
        log_lb, log_1m_lb = jnp.log(lb), jnp.log1p(-lb)
        fz = hf.reshape(B, S, HG_HEADS, HG_KEY_DIM).astype(f32)
        log_f = jnp.logaddexp(log_lb, log_1m_lb + jax.nn.log_sigmoid(fz))
        k_in = jnp.exp(log_1m_lb + jax.nn.log_sigmoid(-fz))
        o_a = hgrn2_chunked(hq.reshape(B, S, HG_HEADS, HG_KEY_DIM).astype(f32), k_in,
                            hi.reshape(B, S, HG_HEADS, HG_VAL_DIM).astype(f32), log_f)
        o_a = rms_norm(o_a, hg_norm_gain[l].reshape(HG_HEADS, HG_VAL_DIM))
        o_a = o_a.reshape(B, S, HG_WIDTH).astype(x.dtype) * jax.nn.silu(hg)

        lam_init = 0.8 - 0.6 * math.exp(-0.3 * l)
        lam = (jnp.exp(jnp.sum(lambda_q1[l].astype(f32) * lambda_k1[l].astype(f32)))
               - jnp.exp(jnp.sum(lambda_q2[l].astype(f32) * lambda_k2[l].astype(f32))) + lam_init)
        o_b = diff_attention(dq.reshape(B, S, DIFF_HEADS, 2, DIFF_HEAD_DIM),
                             dk.reshape(B, S, DIFF_HEADS, 2, DIFF_HEAD_DIM),
                             dv.reshape(B, S, DIFF_HEADS, 2 * DIFF_HEAD_DIM), lam)
        o_b = rms_norm(o_b, diff_norm_gain[l].reshape(DIFF_HEADS, 2 * DIFF_HEAD_DIM)) * (1.0 - lam_init)
        o_b = o_b.reshape(B, S, DIFF_V_WIDTH).astype(x.dtype) * jax.nn.silu(dg)

        y = jax.nn.sigmoid(ma) * (o_a @ w_branch_a[l]) + jax.nn.sigmoid(mb) * (o_b @ w_branch_b[l])
        y = y @ w_out[l]

        x = x + gate[:, None, :] * rms_norm(y, g_post[l])
    return x
```

```cpp
#include <hip/hip_runtime.h>
#include <hip/hip_cooperative_groups.h>
#include <cstdio>
#include <cstdint>
namespace cg = cooperative_groups;
#include <hip/hip_bf16.h>
#include <cmath>
namespace attn_body {
using bf16=__hip_bfloat16;
using bf16x8=__attribute__((ext_vector_type(8)))short;
using s16x4=__attribute__((ext_vector_type(4)))short;
using f32x16=__attribute__((ext_vector_type(16)))float;
using u32x4=__attribute__((ext_vector_type(4)))unsigned;
constexpr int SEQ=8192,D=64,PIN=6144,PO=1024;
constexpr int NW=8,QBLK=32,QB=QBLK*NW,KVBLK=64,NQB=SEQ/QB;
constexpr int ATTN_UNIT_ROWS=QB;
__device__ __forceinline__ int crow(int r,int hi){return (r&3)+8*(r>>2)+4*hi;}
#define SBAR() __builtin_amdgcn_sched_barrier(0)
__device__ __forceinline__ void cmask(f32x16&p0,f32x16&p1,int jb,int qrel,int hi){
  const float NEG=-INFINITY; int kb=64*jb+4*hi;
  #pragma unroll
  for(int r=0;r<16;++r){int kv=kb+(r&3)+8*(r>>2); if(kv>qrel)p0[r]=NEG; if(kv+32>qrel)p1[r]=NEG;}
}

constexpr int NSLOT=3, SLOTB=8192;
constexpr int LDS_K=0, LDS_V=NSLOT*SLOTB, LDS_WS=2*NSLOT*SLOTB, LDS_OST=LDS_WS+NW*64*4, LDS_BYTES=LDS_OST+NW*4096;
constexpr float C2=0.125f*1.4426950408889634f;
__device__ __forceinline__ void glds16(const void*gsrc,unsigned lds_dst){unsigned keep;
  asm volatile("s_mov_b32 %0, m0\n\ts_mov_b32 m0, %2\n\ts_nop 0\n\tglobal_load_lds_dwordx4 %1, off\n\ts_mov_b32 m0, %0":"=&s"(keep):"v"(gsrc),"s"(lds_dst):"memory");}
__device__ __forceinline__ float max3f(float a,float b,float c){float r;asm("v_max3_f32 %0, %1, %2, %3":"=v"(r):"v"(a),"v"(b),"v"(c));return r;}
__device__ __forceinline__ float max2f(float a,float b){float r;asm("v_max_f32_e32 %0, %1, %2":"=v"(r):"v"(a),"v"(b));return r;}
__device__ __forceinline__ float fadd_s(float a,float b){float r;asm("v_add_f32_e32 %0, %1, %2":"=v"(r):"v"(a),"v"(b));return r;}
__device__ __forceinline__ float fsub_s(float a,float b){float r;asm("v_sub_f32_e32 %0, %1, %2":"=v"(r):"v"(a),"v"(b));return r;}
typedef float f32x2_t __attribute__((ext_vector_type(2))); typedef __bf16 bf16x2_t __attribute__((ext_vector_type(2)));
__device__ __forceinline__ unsigned cvtpk_s(float lo,float hi){f32x2_t v={lo,hi};bf16x2_t b=__builtin_convertvector(v,bf16x2_t);return __builtin_bit_cast(unsigned,b);}
#define WAIT_BAR(N) asm volatile("s_waitcnt vmcnt(" #N ") lgkmcnt(0)\n\ts_barrier":::"memory")

__device__ __forceinline__ void qkt(f32x16&p0,f32x16&p1,const char*Kslot,const bf16x8*qr,const f32x16&negm,int r32,int hi){
  const char*kb=Kslot+hi*1024+r32*16;
  #pragma unroll
  for(int d0=0;d0<4;++d0){
    const bf16x8 b0=*reinterpret_cast<const bf16x8*>(kb+d0*2048);
    const bf16x8 b1=*reinterpret_cast<const bf16x8*>(kb+d0*2048+512);
    if(d0==0){p0=__builtin_amdgcn_mfma_f32_32x32x16_bf16(b0,qr[0],negm,0,0,0);p1=__builtin_amdgcn_mfma_f32_32x32x16_bf16(b1,qr[0],negm,0,0,0);}
    else{p0=__builtin_amdgcn_mfma_f32_32x32x16_bf16(b0,qr[d0],p0,0,0,0);p1=__builtin_amdgcn_mfma_f32_32x32x16_bf16(b1,qr[d0],p1,0,0,0);}}
}
typedef __attribute__((address_space(3))) const char* lds_cptr;
typedef short v4i16_t __attribute__((ext_vector_type(4)));
__device__ __forceinline__ void kload8(bf16x8*kf,lds_cptr kp){
  kf[0]=*(const __attribute__((address_space(3))) bf16x8*)(kp);      kf[1]=*(const __attribute__((address_space(3))) bf16x8*)(kp+512);
  kf[2]=*(const __attribute__((address_space(3))) bf16x8*)(kp+2048); kf[3]=*(const __attribute__((address_space(3))) bf16x8*)(kp+2560);
  kf[4]=*(const __attribute__((address_space(3))) bf16x8*)(kp+4096); kf[5]=*(const __attribute__((address_space(3))) bf16x8*)(kp+4608);
  kf[6]=*(const __attribute__((address_space(3))) bf16x8*)(kp+6144); kf[7]=*(const __attribute__((address_space(3))) bf16x8*)(kp+6656);
}
__device__ __forceinline__ void kload2(bf16x8*kf,lds_cptr kp,int j){ kf[2*j]=*(const __attribute__((address_space(3))) bf16x8*)(kp+j*2048); kf[2*j+1]=*(const __attribute__((address_space(3))) bf16x8*)(kp+j*2048+512); }
__device__ __forceinline__ s16x4 vtr(lds_cptr p){ return __builtin_bit_cast(s16x4,__builtin_amdgcn_ds_read_tr16_b64_v4i16((__attribute__((address_space(3))) v4i16_t*)p)); }
__device__ __forceinline__ float rowmax(const f32x16&p0,const f32x16&p1){
  float a=max3f(p0[0],p0[1],p1[0]),b=max3f(p0[2],p0[3],p1[1]);a=max3f(a,p1[2],p1[3]);
  #pragma unroll
  for(int r=4;r<16;r+=4){a=max3f(a,p0[r],p0[r+1]);b=max3f(b,p0[r+2],p0[r+3]);a=max3f(a,p1[r],p1[r+1]);b=max3f(b,p1[r+2],p1[r+3]);}
  const float m=max2f(a,b);
  auto rr=__builtin_amdgcn_permlane32_swap(__float_as_uint(m),__float_as_uint(m),false,false);
  return max2f(__uint_as_float(rr[0]),__uint_as_float(rr[1]));
}
__device__ __forceinline__ void pv(f32x16*o,int vb,bf16x8 pa0,bf16x8 pa1,bf16x8 pa2,bf16x8 pa3){
  #pragma unroll
  for(int d0=0;d0<2;++d0){s16x4 lo[4],hi[4];
    #pragma unroll
    for(int ks=0;ks<4;++ks){
      asm volatile("ds_read_b64_tr_b16 %0,%1 offset:%c2":"=&v"(lo[ks]):"v"(vb),"i"(d0*4096+ks*1024):"memory");
      asm volatile("ds_read_b64_tr_b16 %0,%1 offset:%c2":"=&v"(hi[ks]):"v"(vb),"i"(d0*4096+ks*1024+512):"memory");}
    asm volatile("s_waitcnt lgkmcnt(0)":::"memory");SBAR();
    #define PK(k) (bf16x8){lo[k][0],lo[k][1],lo[k][2],lo[k][3],hi[k][0],hi[k][1],hi[k][2],hi[k][3]}
    o[d0]=__builtin_amdgcn_mfma_f32_32x32x16_bf16(pa0,PK(0),o[d0],0,0,0);
    o[d0]=__builtin_amdgcn_mfma_f32_32x32x16_bf16(pa1,PK(1),o[d0],0,0,0);
    o[d0]=__builtin_amdgcn_mfma_f32_32x32x16_bf16(pa2,PK(2),o[d0],0,0,0);
    o[d0]=__builtin_amdgcn_mfma_f32_32x32x16_bf16(pa3,PK(3),o[d0],0,0,0);
    #undef PK
  }
}

#ifndef ATTN_STORE16
#define ATTN_STORE16(p,v) (*(u32x4*)(p)=(v))
#endif
template<int THRL> __device__ __forceinline__ void attn_unit(int b,int h,int qb,const bf16*Q,const bf16*__restrict__ K,const bf16*__restrict__ V,bf16*O,char*shm){
  const int tid=threadIdx.x,lane=tid&63,r32=lane&31,hi=lane>>5; const int wid=__builtin_amdgcn_readfirstlane(tid>>6);
  const long rowbase=(long)b*SEQ; const int q0=qb*QB;
  const bf16*Qw=Q+(rowbase+q0+wid*QBLK)*PIN;
  const bf16*Kh=K+rowbase*PIN,*Vh=V+rowbase*PIN;
  const unsigned lds0=(unsigned)(uintptr_t)shm;
  float*wsf=(float*)(shm+LDS_WS)+wid*64;
  const bf16*ksrc=Kh+(long)lane*PIN+wid*8;
  const bf16*vsrc=Vh+(long)(16*(wid&3)+(lane>>2))*PIN+(wid>>2)*32+(lane&3)*8;
  const unsigned kdst=lds0+LDS_K+wid*1024, vdst=lds0+LDS_V+wid*1024;
  #define DMA_K(t,slot) glds16(ksrc+(long)(t)*KVBLK*PIN,(unsigned)__builtin_amdgcn_readfirstlane(kdst+(slot)))
  #define DMA_V(t,slot) glds16(vsrc+(long)(t)*KVBLK*PIN,(unsigned)__builtin_amdgcn_readfirstlane(vdst+(slot)))
  const int vb0=(int)(lds0+LDS_V)+((lane>>4)&1)*32+(lane&3)*8+(4*hi+((lane&15)>>2))*64;
  const char*Kbase=shm+LDS_K; bf16x8 kf[8];
  const lds_cptr shm3=(lds_cptr)shm; const lds_cptr kp0=shm3+LDS_K+hi*1024+r32*16; const lds_cptr vp0=shm3+LDS_V+((lane>>4)&1)*32+(lane&3)*8+(4*hi+((lane&15)>>2))*64;
  const int NT=(q0+QB)/KVBLK;
  DMA_K(0,0);DMA_V(0,0);DMA_K(1,SLOTB);
  bf16x8 qr[4];
  #pragma unroll
  for(int d0=0;d0<4;++d0)qr[d0]=*reinterpret_cast<const bf16x8*>(&Qw[(long)r32*PIN+d0*16+hi*8]);
  float mhat=0.f,l_reg=0.f;float zz_;asm volatile("v_mov_b32 %0, 0":"=v"(zz_));f32x16 o[2];_Pragma("unroll") for(int r=0;r<16;++r){o[0][r]=zz_;o[1][r]=zz_;}f32x16 negm;_Pragma("unroll") for(int r=0;r<16;++r)negm[r]=zz_;asm volatile("":"+v"(negm));
  const int qrel=wid*QBLK+r32;
  #define CMASK(P0,P1,t) do{int jb_=(t)-(NT-4); if(jb_>=0)cmask(P0,P1,jb_,qrel,hi);}while(0)
  bool resc=false;
  #define START(P0,P1) do{ const float rm=rowmax(P0,P1); resc=false; \
    { const float dl=rm; mhat=fadd_s(mhat,dl); \
      _Pragma("unroll") for(int r=0;r<16;++r){P0[r]=fsub_s(P0[r],dl);P1[r]=fsub_s(P1[r],dl);} \
      _Pragma("unroll") for(int r=0;r<16;++r)negm[r]=-mhat; asm volatile("":"+v"(negm)); } \
    _Pragma("unroll") for(int r=0;r<16;++r)P0[r]=__builtin_amdgcn_exp2f(P0[r]); }while(0)
  #define RESC() do{ if(resc){ asm volatile("s_waitcnt lgkmcnt(0)":::"memory"); \
      _Pragma("unroll") for(int d_=0;d_<2;++d_) _Pragma("unroll") for(int r=0;r<16;++r)o[d_][r]*=wsf[crow(r,hi)]; } }while(0)
  f32x16 pA0,pA1,pB0,pB1;
  int sl_prev=0,sl_cur=0,sl_next=SLOTB;
  #define ROT() do{sl_prev=sl_cur;sl_cur=sl_next;sl_next=(sl_next==(NSLOT-1)*SLOTB)?0:sl_next+SLOTB;}while(0)
  DMA_K(2,2*SLOTB);
  WAIT_BAR(3);
  qkt(pA0,pA1,Kbase,qr,negm,r32,hi);asm volatile("s_nop 15\n\ts_nop 7":"+v"(pA0),"+v"(pA1));CMASK(pA0,pA1,0);
  START(pA0,pA1);
  _Pragma("unroll") for(int r=0;r<16;++r)pA1[r]=__builtin_amdgcn_exp2f(pA1[r]);
  WAIT_BAR(0);
  DMA_K(3,0);DMA_V(1,SLOTB);
  ROT();
  kload8(kf,kp0+sl_cur);
  WAIT_BAR(2);
  s16x4 vlo[8],vhi[8]; u32x4 pw0,pw1,pw2,pw3;
  #define PKW(P,B) cvtpk_s(P[B],P[B+1])
  #define PAF(k) __builtin_bit_cast(bf16x8,pw##k)
  #define VFR(i) (bf16x8){vlo[i][0],vlo[i][1],vlo[i][2],vlo[i][3],vhi[i][0],vhi[i][1],vhi[i][2],vhi[i][3]}
  #define PIN(x) asm volatile("":"+v"(x))
  #define MX3(a,b,c) __builtin_fmaxf(__builtin_fmaxf((a),(b)),(c))
  #define GAPA(MF,A0,A1,A2,A3,W0,W1,PW) do{ MF; sacc+=A0; sacc+=A1; sacc+=A2; sacc+=A3; PIN(sacc); W0; W1; PIN(PW); SBAR(); }while(0)
  #define EX(v) __builtin_amdgcn_exp2f(v)
  #define GAPB(MF,X,B) do{ MF; X[B]=EX(X[B]); X[B+1]=EX(X[B+1]); X[B+2]=EX(X[B+2]); X[B+3]=EX(X[B+3]); PIN(X); SBAR(); }while(0)
  #define VRD(i) do{ vlo[i]=vtr(vp_+(((i)>>2)*4096+((i)&3)*1024)); vhi[i]=vtr(vp_+(((i)>>2)*4096+((i)&3)*1024+512)); }while(0)
  #define KRD(G,j) do{ if(G){ kload2(kf,kp0+sl_next,j); SBAR(); } }while(0)
  #define STEP(C0,C1,P0,P1,t,GK,GV,GL) do{ SBAR(); \
    const lds_cptr vp_=vp0+sl_prev; \
    VRD(0); SBAR(); float sacc=(P0[0]+P0[1]); \
    GAPA(C0=__builtin_amdgcn_mfma_f32_32x32x16_bf16(kf[0],qr[0],negm,0,0,0), P0[2],P0[3],P0[4],P0[5],     pw0[0]=PKW(P0,0), pw0[1]=PKW(P0,2), pw0); \
    VRD(4); SBAR(); GAPA(C1=__builtin_amdgcn_mfma_f32_32x32x16_bf16(kf[1],qr[0],negm,0,0,0), P0[6],P0[7],P0[8],P0[9],     pw0[2]=PKW(P0,4), pw0[3]=PKW(P0,6), pw0); \
    VRD(1); SBAR(); GAPA(C0=__builtin_amdgcn_mfma_f32_32x32x16_bf16(kf[2],qr[1],C0,0,0,0),   P0[10],P0[11],P0[12],P0[13], pw1[0]=PKW(P0,8), pw1[1]=PKW(P0,10), pw1); \
    VRD(5); SBAR(); GAPA(C1=__builtin_amdgcn_mfma_f32_32x32x16_bf16(kf[3],qr[1],C1,0,0,0),   P0[14],P0[15],P1[0],P1[1],   pw1[2]=PKW(P0,12),pw1[3]=PKW(P0,14), pw1); \
    VRD(2); SBAR(); GAPA(C0=__builtin_amdgcn_mfma_f32_32x32x16_bf16(kf[4],qr[2],C0,0,0,0),   P1[2],P1[3],P1[4],P1[5],     pw2[0]=PKW(P1,0), pw2[1]=PKW(P1,2), pw2); \
    VRD(6); SBAR(); GAPA(C1=__builtin_amdgcn_mfma_f32_32x32x16_bf16(kf[5],qr[2],C1,0,0,0),   P1[6],P1[7],P1[8],P1[9],     pw2[2]=PKW(P1,4), pw2[3]=PKW(P1,6), pw2); \
    VRD(3); SBAR(); GAPA(C0=__builtin_amdgcn_mfma_f32_32x32x16_bf16(kf[6],qr[3],C0,0,0,0),   P1[10],P1[11],P1[12],P1[13], pw3[0]=PKW(P1,8), pw3[1]=PKW(P1,10), pw3); \
    VRD(7); SBAR(); GAPA(C1=__builtin_amdgcn_mfma_f32_32x32x16_bf16(kf[7],qr[3],C1,0,0,0),   P1[14],P1[15],0.f,0.f,       pw3[2]=PKW(P1,12),pw3[3]=PKW(P1,14), pw3); \
    l_reg+=sacc; \
    if(GK){DMA_K((t)+3,sl_cur);} if(GV){DMA_V((t)+1,sl_next);} \
    CMASK(C0,C1,t); \
    { float a=MX3(C0[0],C0[1],C1[0]),b=MX3(C0[2],C0[3],C1[1]); a=MX3(a,C1[2],C1[3]); \
      _Pragma("unroll") for(int r=4;r<16;r+=4){a=MX3(a,C0[r],C0[r+1]);b=MX3(b,C0[r+2],C0[r+3]);a=MX3(a,C1[r],C1[r+1]);b=MX3(b,C1[r+2],C1[r+3]);} \
      float rm=__builtin_fmaxf(a,b); { auto rr=__builtin_amdgcn_permlane32_swap(__float_as_uint(rm),__float_as_uint(rm),false,false); rm=__builtin_fmaxf(__uint_as_float(rr[0]),__uint_as_float(rr[1])); } \
      resc=false; \
      if(__builtin_expect(__any(rm>(float)THRL),0)){ const float dl=__builtin_fmaxf(rm,0.f); mhat+=dl; \
        _Pragma("unroll") for(int r=0;r<16;++r){C0[r]-=dl;C1[r]-=dl;} \
        _Pragma("unroll") for(int r=0;r<16;++r)negm[r]=-mhat; asm volatile("":"+v"(negm)); \
        const float f=__builtin_amdgcn_exp2f(-dl); l_reg*=f; if(hi==0)wsf[r32]=f; resc=true; } } \
    SBAR(); \
    GAPB(o[0]=__builtin_amdgcn_mfma_f32_32x32x16_bf16(PAF(0),VFR(0),o[0],0,0,0), C0,0); \
    GAPB(o[1]=__builtin_amdgcn_mfma_f32_32x32x16_bf16(PAF(0),VFR(4),o[1],0,0,0), C0,4); \
    KRD(GL,0); GAPB(o[0]=__builtin_amdgcn_mfma_f32_32x32x16_bf16(PAF(1),VFR(1),o[0],0,0,0), C0,8); \
    KRD(GL,1); GAPB(o[1]=__builtin_amdgcn_mfma_f32_32x32x16_bf16(PAF(1),VFR(5),o[1],0,0,0), C0,12); \
    KRD(GL,2); GAPB(o[0]=__builtin_amdgcn_mfma_f32_32x32x16_bf16(PAF(2),VFR(2),o[0],0,0,0), C1,0); \
    KRD(GL,3); GAPB(o[1]=__builtin_amdgcn_mfma_f32_32x32x16_bf16(PAF(2),VFR(6),o[1],0,0,0), C1,4); \
    GAPB(o[0]=__builtin_amdgcn_mfma_f32_32x32x16_bf16(PAF(3),VFR(3),o[0],0,0,0), C1,8); \
    GAPB(o[1]=__builtin_amdgcn_mfma_f32_32x32x16_bf16(PAF(3),VFR(7),o[1],0,0,0), C1,12); \
    }while(0)
  int t=1;
  #undef CMASK
  #define CMASK(P0,P1,t) do{}while(0)
  for(;t+5<NT;t+=2){
    STEP(pB0,pB1,pA0,pA1,t,true,true,true);     WAIT_BAR(2); RESC(); ROT();
    STEP(pA0,pA1,pB0,pB1,t+1,true,true,true);   WAIT_BAR(2); RESC(); ROT();
  }
  #undef CMASK
  #define CMASK(P0,P1,t) do{int jb_=(t)-(NT-4); if(jb_>=0)cmask(P0,P1,jb_,qrel,hi);}while(0)
  #define ENDW(tt) do{ if((tt)+3<NT){WAIT_BAR(2);} else if((tt)+2<NT){WAIT_BAR(1);} else {WAIT_BAR(0);} }while(0)
  for(;t+1<NT;t+=2){
    STEP(pB0,pB1,pA0,pA1,t,(t+3<NT),(t+1<NT),(t+1<NT));       ENDW(t);   RESC(); ROT();
    STEP(pA0,pA1,pB0,pB1,t+1,(t+4<NT),(t+2<NT),(t+2<NT));     ENDW(t+1); RESC(); ROT();
  }
  STEP(pB0,pB1,pA0,pA1,NT-1,false,false,false); RESC();
  { float sacc=pB0[0]+pB0[1]; _Pragma("unroll") for(int r=2;r<16;++r)sacc+=pB0[r]; _Pragma("unroll") for(int r=0;r<16;++r)sacc+=pB1[r]; l_reg+=sacc;
    pw0=(u32x4){PKW(pB0,0),PKW(pB0,2),PKW(pB0,4),PKW(pB0,6)};pw1=(u32x4){PKW(pB0,8),PKW(pB0,10),PKW(pB0,12),PKW(pB0,14)};pw2=(u32x4){PKW(pB1,0),PKW(pB1,2),PKW(pB1,4),PKW(pB1,6)};pw3=(u32x4){PKW(pB1,8),PKW(pB1,10),PKW(pB1,12),PKW(pB1,14)};
    SBAR(); pv(o,vb0+sl_cur,PAF(0),PAF(1),PAF(2),PAF(3)); }
  #undef PKW
  #undef PAF
  #undef VFR
  #undef PIN
  #undef MX3
  #undef GAPA
  #undef GAPB
  #undef EX
  #undef VRD
  #undef KRD
  #undef STEP
  #undef ENDW
  {auto rr=__builtin_amdgcn_permlane32_swap(__float_as_uint(l_reg),__float_as_uint(l_reg),false,false);l_reg=__uint_as_float(rr[0])+__uint_as_float(rr[1]);}
  if(hi==0)wsf[32+r32]=l_reg;asm volatile("s_waitcnt lgkmcnt(0)":::"memory");
  float rli[16];
  #pragma unroll
  for(int r=0;r<16;++r)rli[r]=__builtin_amdgcn_rcpf(wsf[32+crow(r,hi)]);
  bf16*Ow=O+(rowbase+q0+wid*QBLK)*PO;
  { bf16*stg=(bf16*)(shm+LDS_OST)+wid*2048;
    #pragma unroll
    for(int r=0;r<16;++r){const int orow=crow(r,hi);
      #pragma unroll
      for(int d0=0;d0<2;++d0)stg[orow*64+d0*32+r32]=__float2bfloat16(o[d0][r]*rli[r]);}
    asm volatile("s_waitcnt lgkmcnt(0)":::"memory");
    #pragma unroll
    for(int i=0;i<4;++i){const int row=i*8+(lane>>3),ch=lane&7; const u32x4 v=*(const u32x4*)(stg+row*64+ch*8); ATTN_STORE16(Ow+(long)row*PO+ch*8,v);} }
  asm volatile("s_waitcnt lgkmcnt(0)\n\ts_barrier":::"memory");
  #undef DMA_K
  #undef DMA_V
  #undef CMASK
  #undef START
  #undef RESC
  #undef ROT
}
constexpr int ATTN_LDS_BYTES=LDS_BYTES;
#undef SBAR
#undef WAIT_BAR
}
constexpr int DM = 1024, NB = 8, SEQ = 8192, NTOK = NB * SEQ, NIN = 6144;
constexpr int C_HQ = 0, C_HF = 512, C_HI = 1024, C_HG = 1536, C_DQ = 2048, C_DK = 2560, C_DV = 3072, C_DG = 3584, C_MA = 4096, C_MB = 5120;
constexpr float RMS_EPS = 1e-6f;
constexpr float QSCALE = 0.125f * 1.4426950408889634f;
constexpr float LAM_INIT = 0.2f;
constexpr size_t MiB = 1u << 20;
constexpr size_t WS_ROWSQ = 0, WS_MOD = 512 * 1024, WS_WIN = 1 * MiB, WS_WAB = 13 * MiB, WS_WOUT = 15 * MiB, WS_XN = 32 * MiB, WS_PROJ = 160 * MiB, WS_END = 928 * MiB;
constexpr int LDS_BYTES = 147456;
constexpr int NTHR = 512;

typedef unsigned short bf16_t;
typedef short bf16x8 __attribute__((ext_vector_type(8)));
typedef float f32x4 __attribute__((ext_vector_type(4)));
typedef float f32x2 __attribute__((ext_vector_type(2)));
typedef unsigned u32x4 __attribute__((ext_vector_type(4)));
typedef unsigned u32x2 __attribute__((ext_vector_type(2)));

__device__ __forceinline__ float bf2f(unsigned h) { return __uint_as_float(h << 16); }
__device__ __forceinline__ unsigned f2bf(float f) { unsigned u = __float_as_uint(f); return (u + 0x7fffu + ((u >> 16) & 1u)) >> 16; }
__device__ __forceinline__ unsigned pk2(float lo, float hi) { return f2bf(lo) | (f2bf(hi) << 16); }
__device__ __forceinline__ float wave_sum(float v) {
#pragma unroll
    for (int o = 1; o < 64; o <<= 1) v += __shfl_xor(v, o);
    return v;
}
__device__ __forceinline__ float sigmoidf_(float v) { return 1.0f / (1.0f + __expf(-v)); }

struct Params { const float* in[17]; float* out; unsigned char* ws; };
enum { I_X = 0, I_C, I_WADA, I_BADA, I_GPRE, I_GPOST, I_WIN, I_LB, I_HGG, I_LQ1, I_LK1, I_LQ2, I_LK2, I_DNG, I_WA, I_WB, I_WOUT };

struct Ctx {
    unsigned char* lds; int tid, lane, wave, vcu, G;
    bf16_t *WIN, *WAB, *WOUT, *XN, *PROJ, *OAB, *OB4;
    float *ROWSQ, *MOD, *OARAW;
};

__device__ __forceinline__ void transpose_item(const float* __restrict__ W, int N, bf16_t* WT, int ldt, int koff, float* scr, int item, int lane) {
    const int nblk = N / 32, kb = item / nblk, nb = item % nblk, k0 = 64 * kb, n0 = 32 * nb;
#pragma unroll 8
    for (int i = 0; i < 32; ++i) { const int kk = 2 * i + (lane >> 5); scr[kk * 33 + (lane & 31)] = W[(size_t)(k0 + kk) * N + n0 + (lane & 31)]; }
    asm volatile("s_waitcnt lgkmcnt(0)" ::: "memory");
    const int c = lane & 7;
#pragma unroll
    for (int j = 0; j < 4; ++j) { const int n = (lane >> 3) + 8 * j; const float* s = scr + (8 * c) * 33 + n;
        u32x4 o; o.x = pk2(s[0 * 33], s[1 * 33]); o.y = pk2(s[2 * 33], s[3 * 33]); o.z = pk2(s[4 * 33], s[5 * 33]); o.w = pk2(s[6 * 33], s[7 * 33]);
        *(u32x4*)(WT + (size_t)(n0 + n) * ldt + koff + k0 + 8 * c) = o; }
    asm volatile("s_waitcnt lgkmcnt(0)" ::: "memory");
}

__device__ __forceinline__ void phase_prologue(const Params& P, const Ctx& C) {
    if (C.vcu < 48) {
        float* sc = (float*)(C.lds + 69632); float* red = (float*)(C.lds + 102400);
        const float* cc = P.in[I_C];
        for (int i = C.tid; i < NB * DM; i += NTHR) { const float v = cc[i]; sc[i] = v * sigmoidf_(v); }
        __syncthreads();
        const int n = C.vcu * 64 + C.lane; const float* wa = P.in[I_WADA];
        float acc[NB];
#pragma unroll
        for (int b = 0; b < NB; ++b) acc[b] = 0.f;
#pragma unroll 4
        for (int kk = 0; kk < 128; ++kk) { const int k = C.wave * 128 + kk; const float w = wa[(size_t)k * 3072 + n];
#pragma unroll
            for (int b = 0; b < NB; ++b) acc[b] += sc[b * DM + k] * w; }
#pragma unroll
        for (int b = 0; b < NB; ++b) red[(C.wave * NB + b) * 64 + C.lane] = acc[b];
        __syncthreads();
        { const int bb = C.tid >> 6; float s = 0.f;
#pragma unroll
          for (int w = 0; w < 8; ++w) s += red[(w * NB + bb) * 64 + C.lane];
          C.MOD[bb * 3072 + n] = s + P.in[I_BADA][n]; }
        __syncthreads();
    }
    float* scr = (float*)(C.lds + C.wave * 8448);
    const int gw = C.vcu * 8 + C.wave, NGW = C.G * 8;
    constexpr int IT_IN = 16 * 192, IT_A = 8 * 32, IT_B = 8 * 32, IT_O = 16 * 32;
    for (int it = gw; it < IT_IN + IT_A + IT_B + IT_O; it += NGW) {
        int r = it;
        if (r < IT_IN) { transpose_item(P.in[I_WIN], NIN, C.WIN, DM, 0, scr, r, C.lane); continue; } r -= IT_IN;
        if (r < IT_A) { transpose_item(P.in[I_WA], DM, C.WAB, DM, 0, scr, r, C.lane); continue; } r -= IT_A;
        if (r < IT_B) { transpose_item(P.in[I_WB], DM, C.WAB, DM, 512, scr, r, C.lane); continue; } r -= IT_B;
        transpose_item(P.in[I_WOUT], DM, C.WOUT, DM, 0, scr, r, C.lane);
    }
    for (int i = C.vcu * NTHR + C.tid; i < NTOK; i += C.G * NTHR) C.ROWSQ[i] = 0.f;
}

__device__ __forceinline__ void phase_prenorm(const Params& P, const Ctx& C) {
    const int gw = C.vcu * 8 + C.wave, NGW = C.G * 8;
    const float* gp = P.in[I_GPRE];
    for (int m = gw; m < NTOK; m += NGW) {
        const int b = m >> 13;
        const f32x4* xr = (const f32x4*)(P.in[I_X] + (size_t)m * DM) + C.lane;
        f32x4 v[4]; float s = 0.f;
#pragma unroll
        for (int j = 0; j < 4; ++j) { v[j] = xr[64 * j]; s += (v[j].x * v[j].x + v[j].y * v[j].y) + (v[j].z * v[j].z + v[j].w * v[j].w); }
        const float rstd = rsqrtf(wave_sum(s) * (1.f / DM) + RMS_EPS);
        u32x2* o8 = (u32x2*)(C.XN + (size_t)m * DM) + C.lane;
#pragma unroll
        for (int j = 0; j < 4; ++j) { const int idx = (C.lane + 64 * j) * 4;
            const f32x4 g = *(const f32x4*)(gp + idx), sh = *(const f32x4*)(C.MOD + b * 3072 + idx), sc = *(const f32x4*)(C.MOD + b * 3072 + 1024 + idx);
            const f32x4 h = v[j] * rstd * g * (sc + 1.0f) + sh;
            u32x2 o; o.x = pk2(h.x, h.y); o.y = pk2(h.z, h.w); o8[64 * j] = o; }
    }
}

template <class Epi>
__device__ __forceinline__ void gemm_simple(const bf16_t* __restrict__ A, int lda, const bf16_t* __restrict__ Bt, int ldb, int M, int N, int K, const Ctx& C, const Epi& E) {
    const int fr = C.lane & 15, fq = C.lane >> 4, wm = C.wave >> 2, wn = C.wave & 3;
    const int ntn = N / 256, ntiles = (M / 128) * ntn;
    for (int tile = C.vcu; tile < ntiles; tile += C.G) {
        const int tm = tile / ntn, tn = tile % ntn, m0 = tm * 128 + wm * 64, n0 = tn * 256 + wn * 64;
        f32x4 acc[4][4];
#pragma unroll
        for (int i = 0; i < 4; ++i)
#pragma unroll
            for (int j = 0; j < 4; ++j) acc[i][j] = (f32x4){0.f, 0.f, 0.f, 0.f};
        const bf16_t* ap = A + (size_t)(m0 + fr) * lda + fq * 8; const bf16_t* bp = Bt + (size_t)(n0 + fr) * ldb + fq * 8;
        for (int k0 = 0; k0 < K; k0 += 32) {
            if (Epi::MID) { if (k0 == K / 2) E.mid(acc, m0, n0, fr, fq); }
            bf16x8 a[4], b[4];
#pragma unroll
            for (int i = 0; i < 4; ++i) { a[i] = *(const bf16x8*)(ap + (size_t)i * 16 * lda + k0); b[i] = *(const bf16x8*)(bp + (size_t)i * 16 * ldb + k0); }
#pragma unroll
            for (int mi = 0; mi < 4; ++mi)
#pragma unroll
                for (int ni = 0; ni < 4; ++ni) acc[mi][ni] = __builtin_amdgcn_mfma_f32_16x16x32_bf16(b[ni], a[mi], acc[mi][ni], 0, 0, 0);
        }
        E(acc, m0, n0, fr, fq);
    }
}
struct EpiProj {
    static constexpr bool MID = false; bf16_t* O;
    __device__ __forceinline__ void mid(f32x4 (&)[4][4], int, int, int, int) const {}
    __device__ __forceinline__ void operator()(const f32x4 (&acc)[4][4], int m0, int n0, int fr, int fq) const {
        const float sc = (n0 >= C_DQ && n0 < C_DK) ? QSCALE : 1.0f;
#pragma unroll
        for (int mi = 0; mi < 4; ++mi)
#pragma unroll
            for (int ni = 0; ni < 4; ++ni) { const f32x4 v = acc[mi][ni] * sc; u32x2 o; o.x = pk2(v.x, v.y); o.y = pk2(v.z, v.w);
                *(u32x2*)(O + (size_t)(m0 + 16 * mi + fr) * NIN + n0 + 16 * ni + 4 * fq) = o; }
    }
};
struct EpiMerge {
    static constexpr bool MID = true; const bf16_t* PROJ; bf16_t* Y;
    __device__ __forceinline__ void mid(f32x4 (&acc)[4][4], int m0, int n0, int fr, int fq) const {
#pragma unroll
        for (int mi = 0; mi < 4; ++mi)
#pragma unroll
            for (int ni = 0; ni < 4; ++ni) { const bf16_t* p = PROJ + (size_t)(m0 + 16 * mi + fr) * NIN + n0 + 16 * ni + 4 * fq;
                const u32x2 a = *(const u32x2*)(p + C_MA), b = *(const u32x2*)(p + C_MB);
                const float a0 = bf2f(a.x & 0xffffu), a1 = bf2f(a.x >> 16), a2 = bf2f(a.y & 0xffffu), a3 = bf2f(a.y >> 16);
                const float b0 = bf2f(b.x & 0xffffu), b1 = bf2f(b.x >> 16), b2 = bf2f(b.y & 0xffffu), b3 = bf2f(b.y >> 16);
                f32x4 r; r.x = (1.f + __expf(-b0)) / (1.f + __expf(-a0)); r.y = (1.f + __expf(-b1)) / (1.f + __expf(-a1));
                r.z = (1.f + __expf(-b2)) / (1.f + __expf(-a2)); r.w = (1.f + __expf(-b3)) / (1.f + __expf(-a3));
                acc[mi][ni] = acc[mi][ni] * r; }
    }
    __device__ __forceinline__ void operator()(const f32x4 (&acc)[4][4], int m0, int n0, int fr, int fq) const {
#pragma unroll
        for (int mi = 0; mi < 4; ++mi)
#pragma unroll
            for (int ni = 0; ni < 4; ++ni) { const size_t off = (size_t)(m0 + 16 * mi + fr) * NIN + n0 + 16 * ni + 4 * fq;
                const u32x2 b = *(const u32x2*)(PROJ + off + C_MB);
                f32x4 s; s.x = sigmoidf_(bf2f(b.x & 0xffffu)); s.y = sigmoidf_(bf2f(b.x >> 16)); s.z = sigmoidf_(bf2f(b.y & 0xffffu)); s.w = sigmoidf_(bf2f(b.y >> 16));
                const f32x4 v = acc[mi][ni] * s; u32x2 o; o.x = pk2(v.x, v.y); o.y = pk2(v.z, v.w);
                *(u32x2*)(Y + off) = o; }
    }
};
struct EpiZ {
    static constexpr bool MID = false; float* Z; float* ROWSQ;
    __device__ __forceinline__ void mid(f32x4 (&)[4][4], int, int, int, int) const {}
    __device__ __forceinline__ void operator()(const f32x4 (&acc)[4][4], int m0, int n0, int fr, int fq) const {
#pragma unroll
        for (int mi = 0; mi < 4; ++mi) { float s = 0.f;
#pragma unroll
            for (int ni = 0; ni < 4; ++ni) { const f32x4 v = acc[mi][ni]; s += (v.x * v.x + v.y * v.y) + (v.z * v.z + v.w * v.w);
                *(f32x4*)(Z + (size_t)(m0 + 16 * mi + fr) * DM + n0 + 16 * ni + 4 * fq) = v; }
            s += __shfl_xor(s, 16); s += __shfl_xor(s, 32);
            if (fq == 0) atomicAdd(ROWSQ + m0 + 16 * mi + fr, s); }
    }
};

__device__ __forceinline__ void phase_hgrn_naive(const Params& P, const Ctx& C) {
    float* qs = (float*)C.lds; float* fs = qs + 8192; float* ks = fs + 8192; float* vs = ks + 8192; float* part = vs + 1024; float* lbs = part + 8192;
    const int e = C.tid & 15, dg = C.tid >> 4;
    for (int unit = C.vcu; unit < 256; unit += C.G) {
        const int b = unit >> 5, h = (unit >> 3) & 3, es = unit & 7;
        __syncthreads();
        if (C.tid < 128) { const float l0 = P.in[I_LB][h * 128 + C.tid], l1 = P.in[I_LB][512 + h * 128 + C.tid]; lbs[C.tid] = 1.0f / (1.0f + __expf(l1 - l0)); }
        __syncthreads();
        float S0 = 0.f, S1 = 0.f, S2 = 0.f, S3 = 0.f;
        for (int c = 0; c < SEQ / 64; ++c) {
            const size_t row0 = (size_t)b * SEQ + c * 64;
#pragma unroll 4
            for (int j = 0; j < 16; ++j) { const int idx = C.tid + NTHR * j, t = idx >> 7, d = idx & 127;
                const bf16_t* p = C.PROJ + (row0 + t) * NIN + h * 128 + d;
                const float q = bf2f(p[C_HQ]), fz = bf2f(p[C_HF]), sg = sigmoidf_(fz), lb = lbs[d];
                qs[idx] = q; fs[idx] = lb + (1.f - lb) * sg; ks[idx] = (1.f - lb) * sigmoidf_(-fz); }
#pragma unroll
            for (int j = 0; j < 2; ++j) { const int idx = C.tid + NTHR * j, t = idx >> 4, ee = idx & 15;
                vs[idx] = bf2f(C.PROJ[(row0 + t) * NIN + C_HI + h * 128 + es * 16 + ee]); }
            __syncthreads();
            for (int t = 0; t < 64; ++t) {
                const f32x4 f4 = *(const f32x4*)(fs + t * 128 + dg * 4), k4 = *(const f32x4*)(ks + t * 128 + dg * 4), q4 = *(const f32x4*)(qs + t * 128 + dg * 4);
                const float v = vs[t * 16 + e];
                S0 = f4.x * S0 + k4.x * v; S1 = f4.y * S1 + k4.y * v; S2 = f4.z * S2 + k4.z * v; S3 = f4.w * S3 + k4.w * v;
                float po = (S0 * q4.x + S1 * q4.y) + (S2 * q4.z + S3 * q4.w);
                po += __shfl_xor(po, 16); po += __shfl_xor(po, 32);
                if (C.lane < 16) part[(t * 8 + C.wave) * 16 + C.lane] = po;
            }
            __syncthreads();
#pragma unroll
            for (int j = 0; j < 2; ++j) { const int idx = C.tid + NTHR * j, t = idx >> 4, ee = idx & 15; float s = 0.f;
#pragma unroll
                for (int w = 0; w < 8; ++w) s += part[(t * 8 + w) * 16 + ee];
                C.OARAW[(row0 + t) * 512 + h * 128 + es * 16 + ee] = s; }
            __syncthreads();
        }
    }
}

__device__ __forceinline__ void phase_attn(const Ctx& C) {
    const int nit = (C.vcu < 256) ? 16 * ((256 - C.vcu + C.G - 1) / C.G) : 0;
    for (int it = 0; it < nit; ++it) {
        const int slot = C.vcu + (it >> 4) * C.G, i = it & 15;
        const int b = slot >> 5, h = (slot >> 3) & 3, j = (slot >> 2) & 1, vh = (slot >> 1) & 1, p = slot & 1;
        const attn_body::bf16* Q = (const attn_body::bf16*)(C.PROJ + C_DQ + (h * 2 + j) * 64);
        const attn_body::bf16* K = (const attn_body::bf16*)(C.PROJ + C_DK + (h * 2 + j) * 64);
        const attn_body::bf16* V = (const attn_body::bf16*)(C.PROJ + C_DV + h * 128 + vh * 64);
        attn_body::bf16* O = (attn_body::bf16*)(C.OB4 + (h * 2 + j) * 128 + vh * 64);
        const int s = 2 * (i >> 1) + p, qb = (i & 1) ? 31 - s : s;
        attn_body::attn_unit<8>(b, 0, qb, Q, K, V, O, (char*)C.lds);
    }
}

__device__ __forceinline__ void phase_branch_norm(const Params& P, const Ctx& C) {
    const int gw = C.vcu * 8 + C.wave, NGW = C.G * 8, l2 = C.lane * 2;
    float s1 = P.in[I_LQ1][C.lane] * P.in[I_LK1][C.lane], s2 = P.in[I_LQ2][C.lane] * P.in[I_LK2][C.lane];
    s1 = wave_sum(s1); s2 = wave_sum(s2);
    const float lam = __expf(s1) - __expf(s2) + LAM_INIT;
    for (int m = gw; m < NTOK; m += NGW) {
        const bf16_t* pr = C.PROJ + (size_t)m * NIN; bf16_t* oab = C.OAB + (size_t)m * DM;
#pragma unroll
        for (int h = 0; h < 4; ++h) {
            {
                const f32x2 o = *(const f32x2*)(C.OARAW + (size_t)m * 512 + h * 128 + l2);
                const float r = rsqrtf(wave_sum(o.x * o.x + o.y * o.y) * (1.f / 128.f) + RMS_EPS);
                const unsigned g = *(const unsigned*)(pr + C_HG + h * 128 + l2); const float g0 = bf2f(g & 0xffffu), g1 = bf2f(g >> 16);
                const f32x2 gn = *(const f32x2*)(P.in[I_HGG] + h * 128 + l2);
                *(unsigned*)(oab + h * 128 + l2) = pk2(o.x * r * gn.x * (g0 * sigmoidf_(g0)), o.y * r * gn.y * (g1 * sigmoidf_(g1)));
            }
            {
                const unsigned u1 = *(const unsigned*)(C.OB4 + (size_t)m * DM + (h * 2 + 0) * 128 + l2), u2 = *(const unsigned*)(C.OB4 + (size_t)m * DM + (h * 2 + 1) * 128 + l2);
                const float o0 = bf2f(u1 & 0xffffu) - lam * bf2f(u2 & 0xffffu), o1 = bf2f(u1 >> 16) - lam * bf2f(u2 >> 16);
                const float r = rsqrtf(wave_sum(o0 * o0 + o1 * o1) * (1.f / 128.f) + RMS_EPS) * (1.0f - LAM_INIT);
                const unsigned g = *(const unsigned*)(pr + C_DG + h * 128 + l2); const float g0 = bf2f(g & 0xffffu), g1 = bf2f(g >> 16);
                const f32x2 gn = *(const f32x2*)(P.in[I_DNG] + h * 128 + l2);
                *(unsigned*)(oab + 512 + h * 128 + l2) = pk2(o0 * r * gn.x * (g0 * sigmoidf_(g0)), o1 * r * gn.y * (g1 * sigmoidf_(g1)));
            }
        }
    }
}

__device__ __forceinline__ void phase_final(const Params& P, const Ctx& C) {
    const int gw = C.vcu * 8 + C.wave, NGW = C.G * 8;
    const float* gpo = P.in[I_GPOST];
    for (int m = gw; m < NTOK; m += NGW) {
        const int b = m >> 13;
        const float rstd = rsqrtf(C.ROWSQ[m] * (1.f / DM) + RMS_EPS);
        const f32x4* xr = (const f32x4*)(P.in[I_X] + (size_t)m * DM) + C.lane; f32x4* zr = (f32x4*)(P.out + (size_t)m * DM) + C.lane;
#pragma unroll
        for (int j = 0; j < 4; ++j) { const int idx = (C.lane + 64 * j) * 4;
            const f32x4 g = *(const f32x4*)(gpo + idx), gt = *(const f32x4*)(C.MOD + b * 3072 + 2048 + idx);
            zr[64 * j] = xr[64 * j] + gt * (zr[64 * j] * rstd * g); }
    }
}

__global__ void __launch_bounds__(NTHR, 2) fwd_kernel(Params P) {
    extern __shared__ __attribute__((aligned(16))) unsigned char lds[];
    cg::grid_group grid = cg::this_grid();
    Ctx C;
    C.lds = lds; C.tid = threadIdx.x; C.lane = C.tid & 63; C.wave = __builtin_amdgcn_readfirstlane(C.tid >> 6);
    C.G = gridDim.x; { const int bx = blockIdx.x; C.vcu = (C.G % 8 == 0) ? (bx % 8) * (C.G / 8) + bx / 8 : bx; }
    unsigned char* ws = P.ws;
    C.ROWSQ = (float*)(ws + WS_ROWSQ); C.MOD = (float*)(ws + WS_MOD);
    C.WIN = (bf16_t*)(ws + WS_WIN); C.WAB = (bf16_t*)(ws + WS_WAB); C.WOUT = (bf16_t*)(ws + WS_WOUT);
    C.XN = (bf16_t*)(ws + WS_XN); C.OAB = C.XN; C.PROJ = (bf16_t*)(ws + WS_PROJ);
    C.OARAW = P.out; C.OB4 = (bf16_t*)((unsigned char*)P.out + 128 * MiB);

#define FRESH() do { int t_ = threadIdx.x; asm volatile("" : "+v"(t_)); C.tid = t_; C.lane = t_ & 63; C.wave = __builtin_amdgcn_readfirstlane(t_ >> 6); } while (0)
    phase_prologue(P, C);
    grid.sync(); FRESH();
    phase_prenorm(P, C);
    grid.sync(); FRESH();
    { EpiProj E{C.PROJ}; gemm_simple(C.XN, DM, C.WIN, DM, NTOK, NIN, DM, C, E); }
    grid.sync(); FRESH();
    phase_hgrn_naive(P, C);
    __syncthreads(); FRESH();
    phase_attn(C);
    grid.sync(); FRESH();
    phase_branch_norm(P, C);
    grid.sync(); FRESH();
    { EpiMerge E{C.PROJ, C.PROJ}; gemm_simple(C.OAB, DM, C.WAB, DM, NTOK, DM, DM, C, E); }
    grid.sync(); FRESH();
    { EpiZ E{P.out, C.ROWSQ}; gemm_simple(C.PROJ, NIN, C.WOUT, DM, NTOK, DM, DM, C, E); }
    grid.sync(); FRESH();
    phase_final(P, C);
}

extern "C" void kernel_launch(void* const* d_in, const int* in_sizes, int n_in, void* d_out, int out_size, void* d_ws, size_t ws_size, hipStream_t stream) {
    static int grid = 0;
    if (grid == 0) {
        if (n_in != 17 || out_size != NTOK * DM || ws_size < WS_END) { fprintf(stderr, "kernel_launch: unexpected shapes (n_in %d out %d ws %zu)\n", n_in, out_size, ws_size); grid = -1; return; }
        int dev = 0, cus = 0, per_cu = 0;
        hipGetDevice(&dev); hipDeviceGetAttribute(&cus, hipDeviceAttributeMultiprocessorCount, dev);
        hipFuncSetAttribute((const void*)fwd_kernel, hipFuncAttributeMaxDynamicSharedMemorySize, LDS_BYTES);
        hipOccupancyMaxActiveBlocksPerMultiprocessor(&per_cu, (const void*)fwd_kernel, NTHR, LDS_BYTES);
        if (per_cu < 1) { fprintf(stderr, "kernel_launch: occupancy query says %d blocks per CU\n", per_cu); per_cu = 1; }
        grid = cus * 1;
        (void)hipGetLastError();
    }
    if (grid < 0) return;
    Params p{};
    for (int i = 0; i < 17; ++i) p.in[i] = (const float*)d_in[i];
    p.out = (float*)d_out; p.ws = (unsigned char*)d_ws;
    void* args[] = {&p};
    hipError_t e = hipLaunchCooperativeKernel((const void*)fwd_kernel, dim3(grid), dim3(NTHR), args, LDS_BYTES, stream);
    if (e != hipSuccess) fprintf(stderr, "cooperative launch failed: %s (grid %d)\n", hipGetErrorString(e), grid);
}
```

```cpp
#include <hip/hip_runtime.h>
#include <hip/hip_cooperative_groups.h>
#include <cstdio>
#include <cstdint>
namespace cg = cooperative_groups;
namespace pg8 {
#define PG8_LAS __attribute__((address_space(3)))
typedef unsigned short bf16_t;
typedef short bf16x8 __attribute__((ext_vector_type(8)));
typedef float f32x4 __attribute__((ext_vector_type(4)));
typedef unsigned u32x4 __attribute__((ext_vector_type(4)));
constexpr int BM = 256, BK = 64, HALF = 128, HTB = HALF * BK * 2  , STAGE_BYTES = 8 * HTB, NXCD = 8, WGM = 8;

__host__ __device__ __forceinline__ int lds_byte(int r, int c) { const int st = (r >> 4) * 2 + (c >> 5), rr = r & 15, cc = c & 31, ob = rr * 64 + cc * 2; return st * 1024 + (ob ^ (((ob >> 9) & 1) << 5)); }
__host__ __device__ __forceinline__ void stage_rc(int b, int& R, int& C) { const int st = b / 1024, sb = b % 1024, swz = sb ^ (((sb >> 9) & 1) << 5); R = (st >> 1) * 16 + swz / 64; C = (st & 1) * 32 + (swz % 64) / 2; }
__host__ __device__ __forceinline__ int perm32(int rho) { const int n = rho >> 4, i = rho & 15; return 8 * (i >> 2) + 4 * n + (i & 3); }

struct Unit { int pm, pn; };
struct Gemm { const bf16_t* A; const bf16_t* Bt; int M, N, K, lda, ldb; };

struct StaticOrder {
    int nM, nN, nwg, G, c;
    __host__ __device__ void init(int M, int N, int G_, int c_) { nM = M / BM; nN = N / BM; nwg = nM * nN; G = G_; c = c_; }
    __host__ __device__ bool next(int i, Unit& u) const {
        const long L = (long)i * G + c; if (L >= nwg) return false;
        int wgid = (int)L; { const int q = nwg / NXCD, r = nwg % NXCD, xcd = wgid % NXCD, off = wgid / NXCD; wgid = (xcd < r ? xcd * (q + 1) : r * (q + 1) + (xcd - r) * q) + off; }
        const int nig = WGM * nN, gid = wgid / nig, fm = gid * WGM, gsz = (nM - fm) < WGM ? (nM - fm) : WGM;
        u.pm = fm + ((wgid % nig) % gsz); u.pn = (wgid % nig) / gsz; return true;
    }
    __device__ __forceinline__ void a_ready(const Unit&) const {}
    __device__ __forceinline__ void done(const Unit&) const {}
};

__device__ __forceinline__ unsigned cvt_pk_bf16(float lo, float hi) { unsigned r; asm volatile("v_cvt_pk_bf16_f32 %0, %1, %2" : "=v"(r) : "v"(lo), "v"(hi)); return r; }
typedef float f32x2 __attribute__((ext_vector_type(2)));
template <class Epi, class Sched, bool ALIGN_EPI = false, bool SP2 = false>
__device__ __forceinline__ void gemm_phase(PG8_LAS unsigned char* lds, const Gemm g, const Sched& S, const Epi& E) {
    int tid_ = threadIdx.x; asm volatile("" : "+v"(tid_));
    const int tid = tid_, wid = __builtin_amdgcn_readfirstlane(tid >> 6), lane = tid & 63, wr = wid >> 2, wc = wid & 3, fr = lane & 15, fq = lane >> 4;
    const int K = g.K, nt = K / BK;
    unsigned voffA[2], voffB[2];
#pragma unroll
    for (int i = 0; i < 2; ++i) { int R, C; stage_rc(tid * 16 + i * 8192, R, C); const int Rb = Epi::PERM ? ((R & ~31) + perm32(R & 31)) : R;
        voffA[i] = (unsigned)(R * g.lda + C) * 2u; voffB[i] = (unsigned)(Rb * g.ldb + C) * 2u; }
    const size_t kstep = (size_t)(BK * 2);
    const size_t hstepA = (size_t)HALF * g.lda * 2, hstepB = (size_t)HALF * g.ldb * 2;
    const size_t tstepA = 2 * hstepA, tstepB = 2 * hstepB;
    const unsigned ldsw = (unsigned)wid * 1024u;
    const int aoff = lds_byte(wr * 64 + fr, fq * 8), boff = lds_byte(wc * 32 + fr, fq * 8);
#define PG8_SA(b, h) (((b) * 2 + (h)) * HTB)
#define PG8_SB(b, h) ((4 + (b) * 2 + (h)) * HTB)
#define PG8_STAGE(bufoff, gbase, voff) do { _Pragma("unroll") for (int _i = 0; _i < 2; ++_i) \
        __builtin_amdgcn_global_load_lds((const unsigned*)((const char*)(gbase) + (voff)[_i]), (PG8_LAS unsigned*)(lds + (bufoff) + ldsw + _i * 8192), 16, 0, 0); } while (0)
#define PG8_LDA(dst, b, h) do { _Pragma("unroll") for (int m = 0; m < 4; ++m) _Pragma("unroll") for (int k = 0; k < 2; ++k) dst[m][k] = *(const PG8_LAS bf16x8*)(lds + PG8_SA(b, h) + aoff + m * 2048 + k * 1024); } while (0)
#define PG8_LDB(dst, b, h) do { _Pragma("unroll") for (int n = 0; n < 2; ++n) _Pragma("unroll") for (int k = 0; k < 2; ++k) dst[n][k] = *(const PG8_LAS bf16x8*)(lds + PG8_SB(b, h) + boff + n * 2048 + k * 1024); } while (0)
#define PG8_MMA(ai, bj, At, Bt) do { __builtin_amdgcn_s_setprio(1); _Pragma("unroll") for (int m = 0; m < 4; ++m) _Pragma("unroll") for (int n = 0; n < 2; ++n) _Pragma("unroll") for (int k = 0; k < 2; ++k) \
        acc[ai][bj][m][n] = __builtin_amdgcn_mfma_f32_16x16x32_bf16(Bt[n][k], At[m][k], acc[ai][bj][m][n], 0, 0, 0); __builtin_amdgcn_s_setprio(0); } while (0)
#define PG8_WAIT_V(n) asm volatile("s_waitcnt vmcnt(" #n ")" ::: "memory")
#define PG8_WAIT_L(n) asm volatile("s_waitcnt lgkmcnt(" #n ")" ::: "memory")
#define PG8_BAR __builtin_amdgcn_s_barrier()
#define PG8_SCHED __builtin_amdgcn_sched_barrier(0)
    Unit cur, nxt; int ui = 0;
    if (!S.next(0, cur)) return;
    f32x4 acc[2][2][4][2];
#pragma unroll
    for (int a = 0; a < 2; ++a)
#pragma unroll
        for (int b = 0; b < 2; ++b)
#pragma unroll
            for (int m = 0; m < 4; ++m)
#pragma unroll
                for (int n = 0; n < 2; ++n) acc[a][b][m][n] = (f32x4){0.f, 0.f, 0.f, 0.f};
    bf16x8 At[4][2], B0[2][2], B1[2][2];
    const char* cA = (const char*)g.A + (size_t)cur.pm * tstepA; const char* cB = (const char*)g.Bt + (size_t)cur.pn * tstepB;
    S.a_ready(cur);
    if constexpr (SP2) {
        PG8_STAGE(PG8_SB(0, 0), cB, voffB); PG8_STAGE(PG8_SB(0, 1), cB + hstepB, voffB); PG8_STAGE(PG8_SA(0, 0), cA, voffA); PG8_STAGE(PG8_SA(0, 1), cA + hstepA, voffA);
        if (wr == 1) PG8_BAR;
        PG8_WAIT_V(2); PG8_BAR;
        PG8_STAGE(PG8_SB(1, 0), cB + kstep, voffB); PG8_STAGE(PG8_SA(1, 0), cA + kstep, voffA); PG8_STAGE(PG8_SB(1, 1), cB + hstepB + kstep, voffB);
        PG8_WAIT_V(6); PG8_BAR;
    } else {
        PG8_STAGE(PG8_SB(0, 0), cB, voffB); PG8_STAGE(PG8_SA(0, 0), cA, voffA); PG8_STAGE(PG8_SB(0, 1), cB + hstepB, voffB); PG8_STAGE(PG8_SA(0, 1), cA + hstepA, voffA);
        if (wr == 1) PG8_BAR;
        PG8_WAIT_V(4); PG8_BAR;
        PG8_STAGE(PG8_SB(1, 0), cB + kstep, voffB); PG8_STAGE(PG8_SA(1, 0), cA + kstep, voffA); PG8_STAGE(PG8_SB(1, 1), cB + hstepB + kstep, voffB);
        PG8_WAIT_V(6); PG8_BAR;
    }
    for (;;) {
        const bool has_next = S.next(ui + 1, nxt);
        const char* nA = has_next ? (const char*)g.A + (size_t)nxt.pm * tstepA : cA; const char* nB = has_next ? (const char*)g.Bt + (size_t)nxt.pn * tstepB : cB;
        for (int t = 0; t < nt; t += 2) {
            const bool last = (t == nt - 2);
            const char* a1 = cA + (size_t)(t + 1) * kstep;
            const char* a2 = last ? nA : cA + (size_t)(t + 2) * kstep; const char* b2 = last ? nB : cB + (size_t)(t + 2) * kstep;
            const char* a3 = a2 + kstep; const char* b3 = b2 + kstep;
            if (last && has_next) S.a_ready(nxt);
            if constexpr (Epi::MID) { if (t == nt / 2) E.mid(acc, cur, wr, wc, fr, fq); }
            if constexpr (SP2) {
            PG8_LDB(B0, 0, 0); PG8_LDB(B1, 0, 1); PG8_SCHED; PG8_LDA(At, 0, 0); PG8_STAGE(PG8_SA(1, 1), a1 + hstepA, voffA);
            PG8_WAIT_V(8); PG8_WAIT_L(0); PG8_BAR; PG8_MMA(0, 0, At, B0); PG8_MMA(0, 1, At, B1); PG8_BAR; PG8_SCHED;
            PG8_LDA(At, 0, 1); PG8_STAGE(PG8_SB(0, 0), b2, voffB); PG8_STAGE(PG8_SB(0, 1), b2 + hstepB, voffB); PG8_STAGE(PG8_SA(0, 0), a2, voffA);
            PG8_WAIT_V(8); PG8_WAIT_L(0); PG8_BAR; PG8_MMA(1, 0, At, B0); PG8_MMA(1, 1, At, B1); PG8_BAR; PG8_SCHED;
            PG8_LDB(B0, 1, 0); PG8_LDB(B1, 1, 1); PG8_SCHED; PG8_LDA(At, 1, 0); PG8_STAGE(PG8_SA(0, 1), a2 + hstepA, voffA);
            PG8_WAIT_V(8); PG8_WAIT_L(0); PG8_BAR; PG8_MMA(0, 0, At, B0); PG8_MMA(0, 1, At, B1); PG8_BAR; PG8_SCHED;
            PG8_LDA(At, 1, 1); PG8_STAGE(PG8_SB(1, 0), b3, voffB); PG8_STAGE(PG8_SB(1, 1), b3 + hstepB, voffB); PG8_STAGE(PG8_SA(1, 0), a3, voffA);
            PG8_WAIT_V(8); PG8_WAIT_L(0); PG8_BAR; PG8_MMA(1, 0, At, B0); PG8_MMA(1, 1, At, B1); PG8_BAR; PG8_SCHED;
            } else {
            PG8_LDB(B0, 0, 0); PG8_SCHED; PG8_LDA(At, 0, 0); PG8_STAGE(PG8_SA(1, 1), a1 + hstepA, voffA);
            PG8_WAIT_L(8); PG8_BAR; PG8_WAIT_L(0); PG8_MMA(0, 0, At, B0); PG8_BAR; PG8_SCHED;
            PG8_LDB(B1, 0, 1); PG8_STAGE(PG8_SB(0, 0), b2, voffB);
            PG8_BAR; PG8_WAIT_L(0); PG8_MMA(0, 1, At, B1); PG8_BAR;
            PG8_LDA(At, 0, 1); PG8_STAGE(PG8_SA(0, 0), a2, voffA);
            PG8_BAR; PG8_WAIT_L(0); PG8_MMA(1, 0, At, B0); PG8_BAR; PG8_SCHED;
            PG8_STAGE(PG8_SB(0, 1), b2 + hstepB, voffB);
            PG8_WAIT_V(6); PG8_BAR; PG8_MMA(1, 1, At, B1); PG8_BAR;
            PG8_LDB(B0, 1, 0); PG8_SCHED; PG8_LDA(At, 1, 0); PG8_STAGE(PG8_SA(0, 1), a2 + hstepA, voffA);
            PG8_WAIT_L(8); PG8_BAR; PG8_WAIT_L(0); PG8_MMA(0, 0, At, B0); PG8_BAR; PG8_SCHED;
            PG8_LDB(B1, 1, 1); PG8_STAGE(PG8_SB(1, 0), b3, voffB);
            PG8_BAR; PG8_WAIT_L(0); PG8_MMA(0, 1, At, B1); PG8_BAR;
            PG8_LDA(At, 1, 1); PG8_STAGE(PG8_SA(1, 0), a3, voffA);
            PG8_BAR; PG8_WAIT_L(0); PG8_MMA(1, 0, At, B0); PG8_BAR; PG8_SCHED;
            PG8_STAGE(PG8_SB(1, 1), b3 + hstepB, voffB);
            PG8_WAIT_V(6); PG8_BAR; PG8_MMA(1, 1, At, B1); PG8_BAR;
            }
        }
        if constexpr (ALIGN_EPI) { if (wr == 0) PG8_BAR; }
        if constexpr (!Epi::AFTER_DRAIN) { E(acc, cur, wr, wc, fr, fq); S.done(cur); }
        if (!has_next) break;
#pragma unroll
        for (int a = 0; a < 2; ++a)
#pragma unroll
            for (int b = 0; b < 2; ++b)
#pragma unroll
                for (int m = 0; m < 4; ++m)
#pragma unroll
                    for (int n = 0; n < 2; ++n) acc[a][b][m][n] = (f32x4){0.f, 0.f, 0.f, 0.f};
        cur = nxt; cA = nA; cB = nB; ++ui;
        if constexpr (ALIGN_EPI) { if (wr == 1) PG8_BAR; }
    }
    PG8_WAIT_V(0);
    if constexpr (!ALIGN_EPI) { if (wr == 0) PG8_BAR; }
    PG8_BAR;
    if constexpr (Epi::AFTER_DRAIN) { E.fused(acc, cur, wr, wc, fr, fq, lds, wid, lane); S.done(cur); }
#undef PG8_SA
#undef PG8_SB
#undef PG8_STAGE
#undef PG8_LDA
#undef PG8_LDB
#undef PG8_MMA
#undef PG8_WAIT_V
#undef PG8_WAIT_L
#undef PG8_BAR
#undef PG8_SCHED
}
}
#include <hip/hip_bf16.h>
#include <cmath>
namespace attn_body {
using bf16=__hip_bfloat16;
using bf16x8=__attribute__((ext_vector_type(8)))short;
using s16x4=__attribute__((ext_vector_type(4)))short;
using f32x16=__attribute__((ext_vector_type(16)))float;
using u32x4=__attribute__((ext_vector_type(4)))unsigned;
constexpr int SEQ=8192,D=64,PIN=6144,PO=1024;
constexpr int NW=8,QBLK=32,QB=QBLK*NW,KVBLK=64,NQB=SEQ/QB;
constexpr int ATTN_UNIT_ROWS=QB;
__device__ __forceinline__ int crow(int r,int hi){return (r&3)+8*(r>>2)+4*hi;}
#define SBAR() __builtin_amdgcn_sched_barrier(0)
__device__ __forceinline__ void cmask(f32x16&p0,f32x16&p1,int jb,int qrel,int hi){
  const float NEG=-INFINITY; int kb=64*jb+4*hi;
  #pragma unroll
  for(int r=0;r<16;++r){int kv=kb+(r&3)+8*(r>>2); if(kv>qrel)p0[r]=NEG; if(kv+32>qrel)p1[r]=NEG;}
}

constexpr int NSLOT=3, SLOTB=8192;
constexpr int LDS_K=0, LDS_V=NSLOT*SLOTB, LDS_WS=2*NSLOT*SLOTB, LDS_OST=LDS_WS+NW*64*4, LDS_BYTES=LDS_OST+NW*4096;
constexpr float C2=0.125f*1.4426950408889634f;
__device__ __forceinline__ void glds16(const void*gsrc,unsigned lds_dst){unsigned keep;
  asm volatile("s_mov_b32 %0, m0\n\ts_mov_b32 m0, %2\n\ts_nop 0\n\tglobal_load_lds_dwordx4 %1, off\n\ts_mov_b32 m0, %0":"=&s"(keep):"v"(gsrc),"s"(lds_dst):"memory");}
__device__ __forceinline__ float max3f(float a,float b,float c){float r;asm("v_max3_f32 %0, %1, %2, %3":"=v"(r):"v"(a),"v"(b),"v"(c));return r;}
__device__ __forceinline__ float max2f(float a,float b){float r;asm("v_max_f32_e32 %0, %1, %2":"=v"(r):"v"(a),"v"(b));return r;}
__device__ __forceinline__ float fadd_s(float a,float b){float r;asm("v_add_f32_e32 %0, %1, %2":"=v"(r):"v"(a),"v"(b));return r;}
__device__ __forceinline__ float fsub_s(float a,float b){float r;asm("v_sub_f32_e32 %0, %1, %2":"=v"(r):"v"(a),"v"(b));return r;}
typedef float f32x2_t __attribute__((ext_vector_type(2))); typedef __bf16 bf16x2_t __attribute__((ext_vector_type(2)));
__device__ __forceinline__ unsigned cvtpk_s(float lo,float hi){f32x2_t v={lo,hi};bf16x2_t b=__builtin_convertvector(v,bf16x2_t);return __builtin_bit_cast(unsigned,b);}
#define WAIT_BAR(N) asm volatile("s_waitcnt vmcnt(" #N ") lgkmcnt(0)\n\ts_barrier":::"memory")

__device__ __forceinline__ void qkt(f32x16&p0,f32x16&p1,const char*Kslot,const bf16x8*qr,const f32x16&negm,int r32,int hi){
  const char*kb=Kslot+hi*1024+r32*16;
  #pragma unroll
  for(int d0=0;d0<4;++d0){
    const bf16x8 b0=*reinterpret_cast<const bf16x8*>(kb+d0*2048);
    const bf16x8 b1=*reinterpret_cast<const bf16x8*>(kb+d0*2048+512);
    if(d0==0){p0=__builtin_amdgcn_mfma_f32_32x32x16_bf16(b0,qr[0],negm,0,0,0);p1=__builtin_amdgcn_mfma_f32_32x32x16_bf16(b1,qr[0],negm,0,0,0);}
    else{p0=__builtin_amdgcn_mfma_f32_32x32x16_bf16(b0,qr[d0],p0,0,0,0);p1=__builtin_amdgcn_mfma_f32_32x32x16_bf16(b1,qr[d0],p1,0,0,0);}}
}
typedef __attribute__((address_space(3))) const char* lds_cptr;
typedef short v4i16_t __attribute__((ext_vector_type(4)));
__device__ __forceinline__ void kload8(bf16x8*kf,lds_cptr kp){
  kf[0]=*(const __attribute__((address_space(3))) bf16x8*)(kp);      kf[1]=*(const __attribute__((address_space(3))) bf16x8*)(kp+512);
  kf[2]=*(const __attribute__((address_space(3))) bf16x8*)(kp+2048); kf[3]=*(const __attribute__((address_space(3))) bf16x8*)(kp+2560);
  kf[4]=*(const __attribute__((address_space(3))) bf16x8*)(kp+4096); kf[5]=*(const __attribute__((address_space(3))) bf16x8*)(kp+4608);
  kf[6]=*(const __attribute__((address_space(3))) bf16x8*)(kp+6144); kf[7]=*(const __attribute__((address_space(3))) bf16x8*)(kp+6656);
}
__device__ __forceinline__ void kload2(bf16x8*kf,lds_cptr kp,int j){ kf[2*j]=*(const __attribute__((address_space(3))) bf16x8*)(kp+j*2048); kf[2*j+1]=*(const __attribute__((address_space(3))) bf16x8*)(kp+j*2048+512); }
__device__ __forceinline__ s16x4 vtr(lds_cptr p){ return __builtin_bit_cast(s16x4,__builtin_amdgcn_ds_read_tr16_b64_v4i16((__attribute__((address_space(3))) v4i16_t*)p)); }
__device__ __forceinline__ float rowmax(const f32x16&p0,const f32x16&p1){
  float a=max3f(p0[0],p0[1],p1[0]),b=max3f(p0[2],p0[3],p1[1]);a=max3f(a,p1[2],p1[3]);
  #pragma unroll
  for(int r=4;r<16;r+=4){a=max3f(a,p0[r],p0[r+1]);b=max3f(b,p0[r+2],p0[r+3]);a=max3f(a,p1[r],p1[r+1]);b=max3f(b,p1[r+2],p1[r+3]);}
  const float m=max2f(a,b);
  auto rr=__builtin_amdgcn_permlane32_swap(__float_as_uint(m),__float_as_uint(m),false,false);
  return max2f(__uint_as_float(rr[0]),__uint_as_float(rr[1]));
}
__device__ __forceinline__ void pv(f32x16*o,int vb,bf16x8 pa0,bf16x8 pa1,bf16x8 pa2,bf16x8 pa3){
  #pragma unroll
  for(int d0=0;d0<2;++d0){s16x4 lo[4],hi[4];
    #pragma unroll
    for(int ks=0;ks<4;++ks){
      asm volatile("ds_read_b64_tr_b16 %0,%1 offset:%c2":"=&v"(lo[ks]):"v"(vb),"i"(d0*4096+ks*1024):"memory");
      asm volatile("ds_read_b64_tr_b16 %0,%1 offset:%c2":"=&v"(hi[ks]):"v"(vb),"i"(d0*4096+ks*1024+512):"memory");}
    asm volatile("s_waitcnt lgkmcnt(0)":::"memory");SBAR();
    #define PK(k) (bf16x8){lo[k][0],lo[k][1],lo[k][2],lo[k][3],hi[k][0],hi[k][1],hi[k][2],hi[k][3]}
    o[d0]=__builtin_amdgcn_mfma_f32_32x32x16_bf16(pa0,PK(0),o[d0],0,0,0);
    o[d0]=__builtin_amdgcn_mfma_f32_32x32x16_bf16(pa1,PK(1),o[d0],0,0,0);
    o[d0]=__builtin_amdgcn_mfma_f32_32x32x16_bf16(pa2,PK(2),o[d0],0,0,0);
    o[d0]=__builtin_amdgcn_mfma_f32_32x32x16_bf16(pa3,PK(3),o[d0],0,0,0);
    #undef PK
  }
}

#ifndef ATTN_STORE16
#define ATTN_STORE16(p,v) (*(u32x4*)(p)=(v))
#endif
template<int THRL> __device__ __forceinline__ void attn_unit(int b,int h,int qb,const bf16*Q,const bf16*__restrict__ K,const bf16*__restrict__ V,bf16*O,char*shm){
  const int tid=threadIdx.x,lane=tid&63,r32=lane&31,hi=lane>>5; const int wid=__builtin_amdgcn_readfirstlane(tid>>6);
  const long rowbase=(long)b*SEQ; const int q0=qb*QB;
  const bf16*Qw=Q+(rowbase+q0+wid*QBLK)*PIN;
  const bf16*Kh=K+rowbase*PIN,*Vh=V+rowbase*PIN;
  const unsigned lds0=(unsigned)(uintptr_t)shm;
  float*wsf=(float*)(shm+LDS_WS)+wid*64;
  const bf16*ksrc=Kh+(long)lane*PIN+wid*8;
  const bf16*vsrc=Vh+(long)(16*(wid&3)+(lane>>2))*PIN+(wid>>2)*32+(lane&3)*8;
  const unsigned kdst=lds0+LDS_K+wid*1024, vdst=lds0+LDS_V+wid*1024;
  #define DMA_K(t,slot) glds16(ksrc+(long)(t)*KVBLK*PIN,(unsigned)__builtin_amdgcn_readfirstlane(kdst+(slot)))
  #define DMA_V(t,slot) glds16(vsrc+(long)(t)*KVBLK*PIN,(unsigned)__builtin_amdgcn_readfirstlane(vdst+(slot)))
  const int vb0=(int)(lds0+LDS_V)+((lane>>4)&1)*32+(lane&3)*8+(4*hi+((lane&15)>>2))*64;
  const char*Kbase=shm+LDS_K; bf16x8 kf[8];
  const lds_cptr shm3=(lds_cptr)shm; const lds_cptr kp0=shm3+LDS_K+hi*1024+r32*16; const lds_cptr vp0=shm3+LDS_V+((lane>>4)&1)*32+(lane&3)*8+(4*hi+((lane&15)>>2))*64;
  const int NT=(q0+QB)/KVBLK;
  DMA_K(0,0);DMA_V(0,0);DMA_K(1,SLOTB);
  bf16x8 qr[4];
  #pragma unroll
  for(int d0=0;d0<4;++d0)qr[d0]=*reinterpret_cast<const bf16x8*>(&Qw[(long)r32*PIN+d0*16+hi*8]);
  float mhat=0.f,l_reg=0.f;float zz_;asm volatile("v_mov_b32 %0, 0":"=v"(zz_));f32x16 o[2];_Pragma("unroll") for(int r=0;r<16;++r){o[0][r]=zz_;o[1][r]=zz_;}f32x16 negm;_Pragma("unroll") for(int r=0;r<16;++r)negm[r]=zz_;asm volatile("":"+v"(negm));
  const int qrel=wid*QBLK+r32;
  #define CMASK(P0,P1,t) do{int jb_=(t)-(NT-4); if(jb_>=0)cmask(P0,P1,jb_,qrel,hi);}while(0)
  bool resc=false;
  #define START(P0,P1) do{ const float rm=rowmax(P0,P1); resc=false; \
    { const float dl=rm; mhat=fadd_s(mhat,dl); \
      _Pragma("unroll") for(int r=0;r<16;++r){P0[r]=fsub_s(P0[r],dl);P1[r]=fsub_s(P1[r],dl);} \
      _Pragma("unroll") for(int r=0;r<16;++r)negm[r]=-mhat; asm volatile("":"+v"(negm)); } \
    _Pragma("unroll") for(int r=0;r<16;++r)P0[r]=__builtin_amdgcn_exp2f(P0[r]); }while(0)
  #define RESC() do{ if(resc){ asm volatile("s_waitcnt lgkmcnt(0)":::"memory"); \
      _Pragma("unroll") for(int d_=0;d_<2;++d_) _Pragma("unroll") for(int r=0;r<16;++r)o[d_][r]*=wsf[crow(r,hi)]; } }while(0)
  f32x16 pA0,pA1,pB0,pB1;
  int sl_prev=0,sl_cur=0,sl_next=SLOTB;
  #define ROT() do{sl_prev=sl_cur;sl_cur=sl_next;sl_next=(sl_next==(NSLOT-1)*SLOTB)?0:sl_next+SLOTB;}while(0)
  DMA_K(2,2*SLOTB);
  WAIT_BAR(3);
  qkt(pA0,pA1,Kbase,qr,negm,r32,hi);asm volatile("s_nop 15\n\ts_nop 7":"+v"(pA0),"+v"(pA1));CMASK(pA0,pA1,0);
  START(pA0,pA1);
  _Pragma("unroll") for(int r=0;r<16;++r)pA1[r]=__builtin_amdgcn_exp2f(pA1[r]);
  WAIT_BAR(0);
  DMA_K(3,0);DMA_V(1,SLOTB);
  ROT();
  kload8(kf,kp0+sl_cur);
  WAIT_BAR(2);
  s16x4 vlo[8],vhi[8]; u32x4 pw0,pw1,pw2,pw3;
  #define PKW(P,B) cvtpk_s(P[B],P[B+1])
  #define PAF(k) __builtin_bit_cast(bf16x8,pw##k)
  #define VFR(i) (bf16x8){vlo[i][0],vlo[i][1],vlo[i][2],vlo[i][3],vhi[i][0],vhi[i][1],vhi[i][2],vhi[i][3]}
  #define PIN(x) asm volatile("":"+v"(x))
  #define MX3(a,b,c) __builtin_fmaxf(__builtin_fmaxf((a),(b)),(c))
  #define GAPA(MF,A0,A1,A2,A3,W0,W1,PW) do{ MF; sacc+=A0; sacc+=A1; sacc+=A2; sacc+=A3; PIN(sacc); W0; W1; PIN(PW); SBAR(); }while(0)
  #define EX(v) __builtin_amdgcn_exp2f(v)
  #define GAPB(MF,X,B) do{ MF; X[B]=EX(X[B]); X[B+1]=EX(X[B+1]); X[B+2]=EX(X[B+2]); X[B+3]=EX(X[B+3]); PIN(X); SBAR(); }while(0)
  #define VRD(i) do{ vlo[i]=vtr(vp_+(((i)>>2)*4096+((i)&3)*1024)); vhi[i]=vtr(vp_+(((i)>>2)*4096+((i)&3)*1024+512)); }while(0)
  #define KRD(G,j) do{ if(G){ kload2(kf,kp0+sl_next,j); SBAR(); } }while(0)
  #define STEP(C0,C1,P0,P1,t,GK,GV,GL) do{ SBAR(); \
    const lds_cptr vp_=vp0+sl_prev; \
    VRD(0); SBAR(); float sacc=(P0[0]+P0[1]); \
    GAPA(C0=__builtin_amdgcn_mfma_f32_32x32x16_bf16(kf[0],qr[0],negm,0,0,0), P0[2],P0[3],P0[4],P0[5],     pw0[0]=PKW(P0,0), pw0[1]=PKW(P0,2), pw0); \
    VRD(4); SBAR(); GAPA(C1=__builtin_amdgcn_mfma_f32_32x32x16_bf16(kf[1],qr[0],negm,0,0,0), P0[6],P0[7],P0[8],P0[9],     pw0[2]=PKW(P0,4), pw0[3]=PKW(P0,6), pw0); \
    VRD(1); SBAR(); GAPA(C0=__builtin_amdgcn_mfma_f32_32x32x16_bf16(kf[2],qr[1],C0,0,0,0),   P0[10],P0[11],P0[12],P0[13], pw1[0]=PKW(P0,8), pw1[1]=PKW(P0,10), pw1); \
    VRD(5); SBAR(); GAPA(C1=__builtin_amdgcn_mfma_f32_32x32x16_bf16(kf[3],qr[1],C1,0,0,0),   P0[14],P0[15],P1[0],P1[1],   pw1[2]=PKW(P0,12),pw1[3]=PKW(P0,14), pw1); \
    VRD(2); SBAR(); GAPA(C0=__builtin_amdgcn_mfma_f32_32x32x16_bf16(kf[4],qr[2],C0,0,0,0),   P1[2],P1[3],P1[4],P1[5],     pw2[0]=PKW(P1,0), pw2[1]=PKW(P1,2), pw2); \
    VRD(6); SBAR(); GAPA(C1=__builtin_amdgcn_mfma_f32_32x32x16_bf16(kf[5],qr[2],C1,0,0,0),   P1[6],P1[7],P1[8],P1[9],     pw2[2]=PKW(P1,4), pw2[3]=PKW(P1,6), pw2); \
    VRD(3); SBAR(); GAPA(C0=__builtin_amdgcn_mfma_f32_32x32x16_bf16(kf[6],qr[3],C0,0,0,0),   P1[10],P1[11],P1[12],P1[13], pw3[0]=PKW(P1,8), pw3[1]=PKW(P1,10), pw3); \
    VRD(7); SBAR(); GAPA(C1=__builtin_amdgcn_mfma_f32_32x32x16_bf16(kf[7],qr[3],C1,0,0,0),   P1[14],P1[15],0.f,0.f,       pw3[2]=PKW(P1,12),pw3[3]=PKW(P1,14), pw3); \
    l_reg+=sacc; \
    if(GK){DMA_K((t)+3,sl_cur);} if(GV){DMA_V((t)+1,sl_next);} \
    CMASK(C0,C1,t); \
    { float a=MX3(C0[0],C0[1],C1[0]),b=MX3(C0[2],C0[3],C1[1]); a=MX3(a,C1[2],C1[3]); \
      _Pragma("unroll") for(int r=4;r<16;r+=4){a=MX3(a,C0[r],C0[r+1]);b=MX3(b,C0[r+2],C0[r+3]);a=MX3(a,C1[r],C1[r+1]);b=MX3(b,C1[r+2],C1[r+3]);} \
      float rm=__builtin_fmaxf(a,b); { auto rr=__builtin_amdgcn_permlane32_swap(__float_as_uint(rm),__float_as_uint(rm),false,false); rm=__builtin_fmaxf(__uint_as_float(rr[0]),__uint_as_float(rr[1])); } \
      resc=false; \
      if(__builtin_expect(__any(rm>(float)THRL),0)){ const float dl=__builtin_fmaxf(rm,0.f); mhat+=dl; \
        _Pragma("unroll") for(int r=0;r<16;++r){C0[r]-=dl;C1[r]-=dl;} \
        _Pragma("unroll") for(int r=0;r<16;++r)negm[r]=-mhat; asm volatile("":"+v"(negm)); \
        const float f=__builtin_amdgcn_exp2f(-dl); l_reg*=f; if(hi==0)wsf[r32]=f; resc=true; } } \
    SBAR(); \
    GAPB(o[0]=__builtin_amdgcn_mfma_f32_32x32x16_bf16(PAF(0),VFR(0),o[0],0,0,0), C0,0); \
    GAPB(o[1]=__builtin_amdgcn_mfma_f32_32x32x16_bf16(PAF(0),VFR(4),o[1],0,0,0), C0,4); \
    KRD(GL,0); GAPB(o[0]=__builtin_amdgcn_mfma_f32_32x32x16_bf16(PAF(1),VFR(1),o[0],0,0,0), C0,8); \
    KRD(GL,1); GAPB(o[1]=__builtin_amdgcn_mfma_f32_32x32x16_bf16(PAF(1),VFR(5),o[1],0,0,0), C0,12); \
    KRD(GL,2); GAPB(o[0]=__builtin_amdgcn_mfma_f32_32x32x16_bf16(PAF(2),VFR(2),o[0],0,0,0), C1,0); \
    KRD(GL,3); GAPB(o[1]=__builtin_amdgcn_mfma_f32_32x32x16_bf16(PAF(2),VFR(6),o[1],0,0,0), C1,4); \
    GAPB(o[0]=__builtin_amdgcn_mfma_f32_32x32x16_bf16(PAF(3),VFR(3),o[0],0,0,0), C1,8); \
    GAPB(o[1]=__builtin_amdgcn_mfma_f32_32x32x16_bf16(PAF(3),VFR(7),o[1],0,0,0), C1,12); \
    }while(0)
  int t=1;
  #undef CMASK
  #define CMASK(P0,P1,t) do{}while(0)
  for(;t+5<NT;t+=2){
    STEP(pB0,pB1,pA0,pA1,t,true,true,true);     WAIT_BAR(2); RESC(); ROT();
    STEP(pA0,pA1,pB0,pB1,t+1,true,true,true);   WAIT_BAR(2); RESC(); ROT();
  }
  #undef CMASK
  #define CMASK(P0,P1,t) do{int jb_=(t)-(NT-4); if(jb_>=0)cmask(P0,P1,jb_,qrel,hi);}while(0)
  #define ENDW(tt) do{ if((tt)+3<NT){WAIT_BAR(2);} else if((tt)+2<NT){WAIT_BAR(1);} else {WAIT_BAR(0);} }while(0)
  for(;t+1<NT;t+=2){
    STEP(pB0,pB1,pA0,pA1,t,(t+3<NT),(t+1<NT),(t+1<NT));       ENDW(t);   RESC(); ROT();
    STEP(pA0,pA1,pB0,pB1,t+1,(t+4<NT),(t+2<NT),(t+2<NT));     ENDW(t+1); RESC(); ROT();
  }
  STEP(pB0,pB1,pA0,pA1,NT-1,false,false,false); RESC();
  { float sacc=pB0[0]+pB0[1]; _Pragma("unroll") for(int r=2;r<16;++r)sacc+=pB0[r]; _Pragma("unroll") for(int r=0;r<16;++r)sacc+=pB1[r]; l_reg+=sacc;
    pw0=(u32x4){PKW(pB0,0),PKW(pB0,2),PKW(pB0,4),PKW(pB0,6)};pw1=(u32x4){PKW(pB0,8),PKW(pB0,10),PKW(pB0,12),PKW(pB0,14)};pw2=(u32x4){PKW(pB1,0),PKW(pB1,2),PKW(pB1,4),PKW(pB1,6)};pw3=(u32x4){PKW(pB1,8),PKW(pB1,10),PKW(pB1,12),PKW(pB1,14)};
    SBAR(); pv(o,vb0+sl_cur,PAF(0),PAF(1),PAF(2),PAF(3)); }
  #undef PKW
  #undef PAF
  #undef VFR
  #undef PIN
  #undef MX3
  #undef GAPA
  #undef GAPB
  #undef EX
  #undef VRD
  #undef KRD
  #undef STEP
  #undef ENDW
  {auto rr=__builtin_amdgcn_permlane32_swap(__float_as_uint(l_reg),__float_as_uint(l_reg),false,false);l_reg=__uint_as_float(rr[0])+__uint_as_float(rr[1]);}
  if(hi==0)wsf[32+r32]=l_reg;asm volatile("s_waitcnt lgkmcnt(0)":::"memory");
  float rli[16];
  #pragma unroll
  for(int r=0;r<16;++r)rli[r]=__builtin_amdgcn_rcpf(wsf[32+crow(r,hi)]);
  bf16*Ow=O+(rowbase+q0+wid*QBLK)*PO;
  { bf16*stg=(bf16*)(shm+LDS_OST)+wid*2048;
    #pragma unroll
    for(int r=0;r<16;++r){const int orow=crow(r,hi);
      #pragma unroll
      for(int d0=0;d0<2;++d0)stg[orow*64+d0*32+r32]=__float2bfloat16(o[d0][r]*rli[r]);}
    asm volatile("s_waitcnt lgkmcnt(0)":::"memory");
    #pragma unroll
    for(int i=0;i<4;++i){const int row=i*8+(lane>>3),ch=lane&7; const u32x4 v=*(const u32x4*)(stg+row*64+ch*8); ATTN_STORE16(Ow+(long)row*PO+ch*8,v);} }
  asm volatile("s_waitcnt lgkmcnt(0)\n\ts_barrier":::"memory");
  #undef DMA_K
  #undef DMA_V
  #undef CMASK
  #undef START
  #undef RESC
  #undef ROT
}
constexpr int ATTN_LDS_BYTES=LDS_BYTES;
#undef SBAR
#undef WAIT_BAR
}
constexpr int DM = 1024, NB = 8, SEQ = 8192, NTOK = NB * SEQ, NIN = 6144;
constexpr int C_HQ = 0, C_HF = 512, C_HI = 1024, C_HG = 1536, C_DQ = 2048, C_DK = 2560, C_DV = 3072, C_DG = 3584, C_MA = 4096, C_MB = 5120;
constexpr float RMS_EPS = 1e-6f;
constexpr float QSCALE = 0.125f * 1.4426950408889634f;
constexpr float LAM_INIT = 0.2f;
constexpr size_t MiB = 1u << 20;
constexpr size_t WS_ROWSQ = 0, WS_MOD = 512 * 1024, WS_WIN = 1 * MiB, WS_WAB = 13 * MiB, WS_WOUT = 15 * MiB, WS_XN = 32 * MiB, WS_PROJ = 160 * MiB, WS_END = 928 * MiB;
constexpr int LDS_BYTES = 147456;
constexpr int NTHR = 512;

typedef unsigned short bf16_t;
typedef short bf16x8 __attribute__((ext_vector_type(8)));
typedef float f32x4 __attribute__((ext_vector_type(4)));
typedef float f32x2 __attribute__((ext_vector_type(2)));
typedef unsigned u32x4 __attribute__((ext_vector_type(4)));
typedef unsigned u32x2 __attribute__((ext_vector_type(2)));

__device__ __forceinline__ float bf2f(unsigned h) { return __uint_as_float(h << 16); }
__device__ __forceinline__ unsigned f2bf(float f) { unsigned u = __float_as_uint(f); return (u + 0x7fffu + ((u >> 16) & 1u)) >> 16; }
__device__ __forceinline__ unsigned pk2(float lo, float hi) { return f2bf(lo) | (f2bf(hi) << 16); }
__device__ __forceinline__ float wave_sum(float v) {
#pragma unroll
    for (int o = 1; o < 64; o <<= 1) v += __shfl_xor(v, o);
    return v;
}
__device__ __forceinline__ float sigmoidf_(float v) { return 1.0f / (1.0f + __expf(-v)); }

struct Params { const float* in[17]; float* out; unsigned char* ws; };
enum { I_X = 0, I_C, I_WADA, I_BADA, I_GPRE, I_GPOST, I_WIN, I_LB, I_HGG, I_LQ1, I_LK1, I_LQ2, I_LK2, I_DNG, I_WA, I_WB, I_WOUT };

struct Ctx {
    unsigned char* lds; int tid, lane, wave, vcu, G;
    bf16_t *WIN, *WAB, *WOUT, *XN, *PROJ, *OAB, *OB4;
    float *ROWSQ, *MOD, *OARAW;
};

__device__ __forceinline__ void transpose_item(const float* __restrict__ W, int N, bf16_t* WT, int ldt, int koff, float* scr, int item, int lane) {
    const int nblk = N / 32, kb = item / nblk, nb = item % nblk, k0 = 64 * kb, n0 = 32 * nb;
#pragma unroll 8
    for (int i = 0; i < 32; ++i) { const int kk = 2 * i + (lane >> 5); scr[kk * 33 + (lane & 31)] = W[(size_t)(k0 + kk) * N + n0 + (lane & 31)]; }
    asm volatile("s_waitcnt lgkmcnt(0)" ::: "memory");
    const int c = lane & 7;
#pragma unroll
    for (int j = 0; j < 4; ++j) { const int n = (lane >> 3) + 8 * j; const float* s = scr + (8 * c) * 33 + n;
        u32x4 o; o.x = pk2(s[0 * 33], s[1 * 33]); o.y = pk2(s[2 * 33], s[3 * 33]); o.z = pk2(s[4 * 33], s[5 * 33]); o.w = pk2(s[6 * 33], s[7 * 33]);
        *(u32x4*)(WT + (size_t)(n0 + n) * ldt + koff + k0 + 8 * c) = o; }
    asm volatile("s_waitcnt lgkmcnt(0)" ::: "memory");
}

__device__ __forceinline__ void phase_prologue(const Params& P, const Ctx& C) {
    if (C.vcu < 48) {
        float* sc = (float*)(C.lds + 69632); float* red = (float*)(C.lds + 102400);
        const float* cc = P.in[I_C];
        for (int i = C.tid; i < NB * DM; i += NTHR) { const float v = cc[i]; sc[i] = v * sigmoidf_(v); }
        __syncthreads();
        const int n = C.vcu * 64 + C.lane; const float* wa = P.in[I_WADA];
        float acc[NB];
#pragma unroll
        for (int b = 0; b < NB; ++b) acc[b] = 0.f;
#pragma unroll 4
        for (int kk = 0; kk < 128; ++kk) { const int k = C.wave * 128 + kk; const float w = wa[(size_t)k * 3072 + n];
#pragma unroll
            for (int b = 0; b < NB; ++b) acc[b] += sc[b * DM + k] * w; }
#pragma unroll
        for (int b = 0; b < NB; ++b) red[(C.wave * NB + b) * 64 + C.lane] = acc[b];
        __syncthreads();
        { const int bb = C.tid >> 6; float s = 0.f;
#pragma unroll
          for (int w = 0; w < 8; ++w) s += red[(w * NB + bb) * 64 + C.lane];
          C.MOD[bb * 3072 + n] = s + P.in[I_BADA][n]; }
        __syncthreads();
    }
    float* scr = (float*)(C.lds + C.wave * 8448);
    const int gw = C.vcu * 8 + C.wave, NGW = C.G * 8;
    constexpr int IT_IN = 16 * 192, IT_A = 8 * 32, IT_B = 8 * 32, IT_O = 16 * 32;
    for (int it = gw; it < IT_IN + IT_A + IT_B + IT_O; it += NGW) {
        int r = it;
        if (r < IT_IN) { transpose_item(P.in[I_WIN], NIN, C.WIN, DM, 0, scr, r, C.lane); continue; } r -= IT_IN;
        if (r < IT_A) { transpose_item(P.in[I_WA], DM, C.WAB, DM, 0, scr, r, C.lane); continue; } r -= IT_A;
        if (r < IT_B) { transpose_item(P.in[I_WB], DM, C.WAB, DM, 512, scr, r, C.lane); continue; } r -= IT_B;
        transpose_item(P.in[I_WOUT], DM, C.WOUT, DM, 0, scr, r, C.lane);
    }
    for (int i = C.vcu * NTHR + C.tid; i < NTOK; i += C.G * NTHR) C.ROWSQ[i] = 0.f;
}

__device__ __forceinline__ void phase_prenorm(const Params& P, const Ctx& C) {
    const int gw = C.vcu * 8 + C.wave, NGW = C.G * 8;
    const float* gp = P.in[I_GPRE];
    for (int m = gw; m < NTOK; m += NGW) {
        const int b = m >> 13;
        const f32x4* xr = (const f32x4*)(P.in[I_X] + (size_t)m * DM) + C.lane;
        f32x4 v[4]; float s = 0.f;
#pragma unroll
        for (int j = 0; j < 4; ++j) { v[j] = xr[64 * j]; s += (v[j].x * v[j].x + v[j].y * v[j].y) + (v[j].z * v[j].z + v[j].w * v[j].w); }
        const float rstd = rsqrtf(wave_sum(s) * (1.f / DM) + RMS_EPS);
        u32x2* o8 = (u32x2*)(C.XN + (size_t)m * DM) + C.lane;
#pragma unroll
        for (int j = 0; j < 4; ++j) { const int idx = (C.lane + 64 * j) * 4;
            const f32x4 g = *(const f32x4*)(gp + idx), sh = *(const f32x4*)(C.MOD + b * 3072 + idx), sc = *(const f32x4*)(C.MOD + b * 3072 + 1024 + idx);
            const f32x4 h = v[j] * rstd * g * (sc + 1.0f) + sh;
            u32x2 o; o.x = pk2(h.x, h.y); o.y = pk2(h.z, h.w); o8[64 * j] = o; }
    }
}

template <class Epi>
__device__ __forceinline__ void gemm_simple(const bf16_t* __restrict__ A, int lda, const bf16_t* __restrict__ Bt, int ldb, int M, int N, int K, const Ctx& C, const Epi& E) {
    const int fr = C.lane & 15, fq = C.lane >> 4, wm = C.wave >> 2, wn = C.wave & 3;
    const int ntn = N / 256, ntiles = (M / 128) * ntn;
    for (int tile = C.vcu; tile < ntiles; tile += C.G) {
        const int tm = tile / ntn, tn = tile % ntn, m0 = tm * 128 + wm * 64, n0 = tn * 256 + wn * 64;
        f32x4 acc[4][4];
#pragma unroll
        for (int i = 0; i < 4; ++i)
#pragma unroll
            for (int j = 0; j < 4; ++j) acc[i][j] = (f32x4){0.f, 0.f, 0.f, 0.f};
        const bf16_t* ap = A + (size_t)(m0 + fr) * lda + fq * 8; const bf16_t* bp = Bt + (size_t)(n0 + fr) * ldb + fq * 8;
        for (int k0 = 0; k0 < K; k0 += 32) {
            if (Epi::MID) { if (k0 == K / 2) E.mid(acc, m0, n0, fr, fq); }
            bf16x8 a[4], b[4];
#pragma unroll
            for (int i = 0; i < 4; ++i) { a[i] = *(const bf16x8*)(ap + (size_t)i * 16 * lda + k0); b[i] = *(const bf16x8*)(bp + (size_t)i * 16 * ldb + k0); }
#pragma unroll
            for (int mi = 0; mi < 4; ++mi)
#pragma unroll
                for (int ni = 0; ni < 4; ++ni) acc[mi][ni] = __builtin_amdgcn_mfma_f32_16x16x32_bf16(b[ni], a[mi], acc[mi][ni], 0, 0, 0);
        }
        E(acc, m0, n0, fr, fq);
    }
}
struct EpiProj {
    static constexpr bool MID = false; bf16_t* O;
    __device__ __forceinline__ void mid(f32x4 (&)[4][4], int, int, int, int) const {}
    __device__ __forceinline__ void operator()(const f32x4 (&acc)[4][4], int m0, int n0, int fr, int fq) const {
        const float sc = (n0 >= C_DQ && n0 < C_DK) ? QSCALE : 1.0f;
#pragma unroll
        for (int mi = 0; mi < 4; ++mi)
#pragma unroll
            for (int ni = 0; ni < 4; ++ni) { const f32x4 v = acc[mi][ni] * sc; u32x2 o; o.x = pk2(v.x, v.y); o.y = pk2(v.z, v.w);
                *(u32x2*)(O + (size_t)(m0 + 16 * mi + fr) * NIN + n0 + 16 * ni + 4 * fq) = o; }
    }
};
struct EpiMerge {
    static constexpr bool MID = true; const bf16_t* PROJ; bf16_t* Y;
    __device__ __forceinline__ void mid(f32x4 (&acc)[4][4], int m0, int n0, int fr, int fq) const {
#pragma unroll
        for (int mi = 0; mi < 4; ++mi)
#pragma unroll
            for (int ni = 0; ni < 4; ++ni) { const bf16_t* p = PROJ + (size_t)(m0 + 16 * mi + fr) * NIN + n0 + 16 * ni + 4 * fq;
                const u32x2 a = *(const u32x2*)(p + C_MA), b = *(const u32x2*)(p + C_MB);
                const float a0 = bf2f(a.x & 0xffffu), a1 = bf2f(a.x >> 16), a2 = bf2f(a.y & 0xffffu), a3 = bf2f(a.y >> 16);
                const float b0 = bf2f(b.x & 0xffffu), b1 = bf2f(b.x >> 16), b2 = bf2f(b.y & 0xffffu), b3 = bf2f(b.y >> 16);
                f32x4 r; r.x = (1.f + __expf(-b0)) / (1.f + __expf(-a0)); r.y = (1.f + __expf(-b1)) / (1.f + __expf(-a1));
                r.z = (1.f + __expf(-b2)) / (1.f + __expf(-a2)); r.w = (1.f + __expf(-b3)) / (1.f + __expf(-a3));
                acc[mi][ni] = acc[mi][ni] * r; }
    }
    __device__ __forceinline__ void operator()(const f32x4 (&acc)[4][4], int m0, int n0, int fr, int fq) const {
#pragma unroll
        for (int mi = 0; mi < 4; ++mi)
#pragma unroll
            for (int ni = 0; ni < 4; ++ni) { const size_t off = (size_t)(m0 + 16 * mi + fr) * NIN + n0 + 16 * ni + 4 * fq;
                const u32x2 b = *(const u32x2*)(PROJ + off + C_MB);
                f32x4 s; s.x = sigmoidf_(bf2f(b.x & 0xffffu)); s.y = sigmoidf_(bf2f(b.x >> 16)); s.z = sigmoidf_(bf2f(b.y & 0xffffu)); s.w = sigmoidf_(bf2f(b.y >> 16));
                const f32x4 v = acc[mi][ni] * s; u32x2 o; o.x = pk2(v.x, v.y); o.y = pk2(v.z, v.w);
                *(u32x2*)(Y + off) = o; }
    }
};
struct EpiZ {
    static constexpr bool MID = false; float* Z; float* ROWSQ;
    __device__ __forceinline__ void mid(f32x4 (&)[4][4], int, int, int, int) const {}
    __device__ __forceinline__ void operator()(const f32x4 (&acc)[4][4], int m0, int n0, int fr, int fq) const {
#pragma unroll
        for (int mi = 0; mi < 4; ++mi) { float s = 0.f;
#pragma unroll
            for (int ni = 0; ni < 4; ++ni) { const f32x4 v = acc[mi][ni]; s += (v.x * v.x + v.y * v.y) + (v.z * v.z + v.w * v.w);
                *(f32x4*)(Z + (size_t)(m0 + 16 * mi + fr) * DM + n0 + 16 * ni + 4 * fq) = v; }
            s += __shfl_xor(s, 16); s += __shfl_xor(s, 32);
            if (fq == 0) atomicAdd(ROWSQ + m0 + 16 * mi + fr, s); }
    }
};


__device__ __forceinline__ unsigned cvtpk(float lo, float hi) { unsigned r; asm volatile("v_cvt_pk_bf16_f32 %0, %1, %2" : "=v"(r) : "v"(lo), "v"(hi)); return r; }
struct EpiProj2 {
    static constexpr bool PERM = true, AFTER_DRAIN = false, MID = false; bf16_t* O;
    __device__ __forceinline__ void mid(f32x4 (&)[2][2][4][2], const pg8::Unit&, int, int, int, int) const {}
    __device__ __forceinline__ void operator()(const f32x4 (&acc)[2][2][4][2], const pg8::Unit& u, int wr, int wc, int fr, int fq) const {
        const float sc = (u.pn == 8 || u.pn == 9) ? QSCALE : 1.0f;
        const int row0 = u.pm * 256 + wr * 64 + fr, col0 = u.pn * 256 + wc * 32 + 8 * fq;
#pragma unroll
        for (int ai = 0; ai < 2; ++ai)
#pragma unroll
            for (int m = 0; m < 4; ++m) { bf16_t* rowp = O + (size_t)(row0 + ai * 128 + m * 16) * NIN + col0;
#pragma unroll
                for (int bj = 0; bj < 2; ++bj) { const f32x4 v0 = acc[ai][bj][m][0] * sc, v1 = acc[ai][bj][m][1] * sc;
                    u32x4 w; w.x = cvtpk(v0[0], v0[1]); w.y = cvtpk(v0[2], v0[3]); w.z = cvtpk(v1[0], v1[1]); w.w = cvtpk(v1[2], v1[3]);
                    *(u32x4*)(rowp + bj * 128) = w; } }
    }
};
__device__ __forceinline__ void unpack8(const u32x4 a, float (&f)[8]) {
    f[0] = bf2f(a.x & 0xffffu); f[1] = bf2f(a.x >> 16); f[2] = bf2f(a.y & 0xffffu); f[3] = bf2f(a.y >> 16);
    f[4] = bf2f(a.z & 0xffffu); f[5] = bf2f(a.z >> 16); f[6] = bf2f(a.w & 0xffffu); f[7] = bf2f(a.w >> 16);
}
struct EpiMerge2 {
    static constexpr bool PERM = true, AFTER_DRAIN = false, MID = true; const bf16_t* PROJ; bf16_t* Y;
    __device__ __forceinline__ void mid(f32x4 (&acc)[2][2][4][2], const pg8::Unit& u, int wr, int wc, int fr, int fq) const {
        asm volatile("" : "+v"(fr), "+v"(fq));
        const int row0 = u.pm * 256 + wr * 64 + fr, col0 = u.pn * 256 + wc * 32 + 8 * fq;
#pragma unroll
        for (int ai = 0; ai < 2; ++ai)
#pragma unroll
            for (int m = 0; m < 4; ++m) { const bf16_t* rowp = PROJ + (size_t)(row0 + ai * 128 + m * 16) * NIN + col0;
#pragma unroll
                for (int bj = 0; bj < 2; ++bj) { float a[8], b[8]; unpack8(*(const u32x4*)(rowp + C_MA + bj * 128), a); unpack8(*(const u32x4*)(rowp + C_MB + bj * 128), b);
                    float r[8];
#pragma unroll
                    for (int i = 0; i < 8; ++i) r[i] = (1.f + __expf(-b[i])) * __builtin_amdgcn_rcpf(1.f + __expf(-a[i]));
                    acc[ai][bj][m][0] = acc[ai][bj][m][0] * (f32x4){r[0], r[1], r[2], r[3]}; acc[ai][bj][m][1] = acc[ai][bj][m][1] * (f32x4){r[4], r[5], r[6], r[7]}; }
                asm volatile("" : "+v"(acc[ai][0][m][0]), "+v"(acc[ai][0][m][1]), "+v"(acc[ai][1][m][0]), "+v"(acc[ai][1][m][1]) :: "memory"); }
    }
    __device__ __forceinline__ void operator()(const f32x4 (&acc)[2][2][4][2], const pg8::Unit& u, int wr, int wc, int fr, int fq) const {
        asm volatile("" : "+v"(fr), "+v"(fq));
        const int row0 = u.pm * 256 + wr * 64 + fr, col0 = u.pn * 256 + wc * 32 + 8 * fq;
#pragma unroll
        for (int ai = 0; ai < 2; ++ai)
#pragma unroll
            for (int m = 0; m < 4; ++m) { const size_t off = (size_t)(row0 + ai * 128 + m * 16) * NIN + col0;
#pragma unroll
                for (int bj = 0; bj < 2; ++bj) { float b[8]; unpack8(*(const u32x4*)(PROJ + off + C_MB + bj * 128), b);
#pragma unroll
                    for (int i = 0; i < 8; ++i) b[i] = __builtin_amdgcn_rcpf(1.f + __expf(-b[i]));
                    const f32x4 v0 = acc[ai][bj][m][0] * (f32x4){b[0], b[1], b[2], b[3]}, v1 = acc[ai][bj][m][1] * (f32x4){b[4], b[5], b[6], b[7]};
                    u32x4 w; w.x = cvtpk(v0[0], v0[1]); w.y = cvtpk(v0[2], v0[3]); w.z = cvtpk(v1[0], v1[1]); w.w = cvtpk(v1[2], v1[3]);
                    *(u32x4*)(Y + off + bj * 128) = w; }
                asm volatile("" ::: "memory"); }
    }
};
struct EpiZ2 {
    static constexpr bool PERM = false, AFTER_DRAIN = false, MID = false; float* Z; float* ROWSQ;
    __device__ __forceinline__ void mid(f32x4 (&)[2][2][4][2], const pg8::Unit&, int, int, int, int) const {}
    __device__ __forceinline__ void operator()(const f32x4 (&acc)[2][2][4][2], const pg8::Unit& u, int wr, int wc, int fr, int fq) const {
        const int row0 = u.pm * 256 + wr * 64 + fr, col0 = u.pn * 256 + wc * 32 + 4 * fq;
#pragma unroll
        for (int ai = 0; ai < 2; ++ai)
#pragma unroll
            for (int m = 0; m < 4; ++m) { const int row = row0 + ai * 128 + m * 16; float s = 0.f;
#pragma unroll
                for (int bj = 0; bj < 2; ++bj)
#pragma unroll
                    for (int n = 0; n < 2; ++n) { const f32x4 v = acc[ai][bj][m][n]; s += (v.x * v.x + v.y * v.y) + (v.z * v.z + v.w * v.w);
                        *(f32x4*)(Z + (size_t)row * DM + col0 + bj * 128 + n * 16) = v; }
                s += __shfl_xor(s, 16); s += __shfl_xor(s, 32);
                if (fq == 0) atomicAdd(ROWSQ + row, s); }
    }
};

__device__ __forceinline__ void phase_hgrn_naive(const Params& P, const Ctx& C) {
    float* qs = (float*)C.lds; float* fs = qs + 8192; float* ks = fs + 8192; float* vs = ks + 8192; float* part = vs + 1024; float* lbs = part + 8192;
    const int e = C.tid & 15, dg = C.tid >> 4;
    for (int unit = C.vcu; unit < 256; unit += C.G) {
        const int b = unit >> 5, h = (unit >> 3) & 3, es = unit & 7;
        __syncthreads();
        if (C.tid < 128) { const float l0 = P.in[I_LB][h * 128 + C.tid], l1 = P.in[I_LB][512 + h * 128 + C.tid]; lbs[C.tid] = 1.0f / (1.0f + __expf(l1 - l0)); }
        __syncthreads();
        float S0 = 0.f, S1 = 0.f, S2 = 0.f, S3 = 0.f;
        for (int c = 0; c < SEQ / 64; ++c) {
            const size_t row0 = (size_t)b * SEQ + c * 64;
#pragma unroll 4
            for (int j = 0; j < 16; ++j) { const int idx = C.tid + NTHR * j, t = idx >> 7, d = idx & 127;
                const bf16_t* p = C.PROJ + (row0 + t) * NIN + h * 128 + d;
                const float q = bf2f(p[C_HQ]), fz = bf2f(p[C_HF]), sg = sigmoidf_(fz), lb = lbs[d];
                qs[idx] = q; fs[idx] = lb + (1.f - lb) * sg; ks[idx] = (1.f - lb) * sigmoidf_(-fz); }
#pragma unroll
            for (int j = 0; j < 2; ++j) { const int idx = C.tid + NTHR * j, t = idx >> 4, ee = idx & 15;
                vs[idx] = bf2f(C.PROJ[(row0 + t) * NIN + C_HI + h * 128 + es * 16 + ee]); }
            __syncthreads();
            for (int t = 0; t < 64; ++t) {
                const f32x4 f4 = *(const f32x4*)(fs + t * 128 + dg * 4), k4 = *(const f32x4*)(ks + t * 128 + dg * 4), q4 = *(const f32x4*)(qs + t * 128 + dg * 4);
                const float v = vs[t * 16 + e];
                S0 = f4.x * S0 + k4.x * v; S1 = f4.y * S1 + k4.y * v; S2 = f4.z * S2 + k4.z * v; S3 = f4.w * S3 + k4.w * v;
                float po = (S0 * q4.x + S1 * q4.y) + (S2 * q4.z + S3 * q4.w);
                po += __shfl_xor(po, 16); po += __shfl_xor(po, 32);
                if (C.lane < 16) part[(t * 8 + C.wave) * 16 + C.lane] = po;
            }
            __syncthreads();
#pragma unroll
            for (int j = 0; j < 2; ++j) { const int idx = C.tid + NTHR * j, t = idx >> 4, ee = idx & 15; float s = 0.f;
#pragma unroll
                for (int w = 0; w < 8; ++w) s += part[(t * 8 + w) * 16 + ee];
                C.OARAW[(row0 + t) * 512 + h * 128 + es * 16 + ee] = s; }
            __syncthreads();
        }
    }
}

__device__ __forceinline__ void phase_attn(const Ctx& C) {
    const int nit = (C.vcu < 256) ? 16 * ((256 - C.vcu + C.G - 1) / C.G) : 0;
    for (int it = 0; it < nit; ++it) {
        const int slot = C.vcu + (it >> 4) * C.G, i = it & 15;
        const int b = slot >> 5, h = (slot >> 3) & 3, j = (slot >> 2) & 1, vh = (slot >> 1) & 1, p = slot & 1;
        const attn_body::bf16* Q = (const attn_body::bf16*)(C.PROJ + C_DQ + (h * 2 + j) * 64);
        const attn_body::bf16* K = (const attn_body::bf16*)(C.PROJ + C_DK + (h * 2 + j) * 64);
        const attn_body::bf16* V = (const attn_body::bf16*)(C.PROJ + C_DV + h * 128 + vh * 64);
        attn_body::bf16* O = (attn_body::bf16*)(C.OB4 + (h * 2 + j) * 128 + vh * 64);
        const int s = 2 * (i >> 1) + p, qb = (i & 1) ? 31 - s : s;
        attn_body::attn_unit<8>(b, 0, qb, Q, K, V, O, (char*)C.lds);
    }
}

__device__ __forceinline__ void phase_branch_norm(const Params& P, const Ctx& C) {
    const int gw = C.vcu * 8 + C.wave, NGW = C.G * 8, l2 = C.lane * 2;
    float s1 = P.in[I_LQ1][C.lane] * P.in[I_LK1][C.lane], s2 = P.in[I_LQ2][C.lane] * P.in[I_LK2][C.lane];
    s1 = wave_sum(s1); s2 = wave_sum(s2);
    const float lam = __expf(s1) - __expf(s2) + LAM_INIT;
    for (int m = gw; m < NTOK; m += NGW) {
        const bf16_t* pr = C.PROJ + (size_t)m * NIN; bf16_t* oab = C.OAB + (size_t)m * DM;
#pragma unroll
        for (int h = 0; h < 4; ++h) {
            {
                const f32x2 o = *(const f32x2*)(C.OARAW + (size_t)m * 512 + h * 128 + l2);
                const float r = rsqrtf(wave_sum(o.x * o.x + o.y * o.y) * (1.f / 128.f) + RMS_EPS);
                const unsigned g = *(const unsigned*)(pr + C_HG + h * 128 + l2); const float g0 = bf2f(g & 0xffffu), g1 = bf2f(g >> 16);
                const f32x2 gn = *(const f32x2*)(P.in[I_HGG] + h * 128 + l2);
                *(unsigned*)(oab + h * 128 + l2) = pk2(o.x * r * gn.x * (g0 * sigmoidf_(g0)), o.y * r * gn.y * (g1 * sigmoidf_(g1)));
            }
            {
                const unsigned u1 = *(const unsigned*)(C.OB4 + (size_t)m * DM + (h * 2 + 0) * 128 + l2), u2 = *(const unsigned*)(C.OB4 + (size_t)m * DM + (h * 2 + 1) * 128 + l2);
                const float o0 = bf2f(u1 & 0xffffu) - lam * bf2f(u2 & 0xffffu), o1 = bf2f(u1 >> 16) - lam * bf2f(u2 >> 16);
                const float r = rsqrtf(wave_sum(o0 * o0 + o1 * o1) * (1.f / 128.f) + RMS_EPS) * (1.0f - LAM_INIT);
                const unsigned g = *(const unsigned*)(pr + C_DG + h * 128 + l2); const float g0 = bf2f(g & 0xffffu), g1 = bf2f(g >> 16);
                const f32x2 gn = *(const f32x2*)(P.in[I_DNG] + h * 128 + l2);
                *(unsigned*)(oab + 512 + h * 128 + l2) = pk2(o0 * r * gn.x * (g0 * sigmoidf_(g0)), o1 * r * gn.y * (g1 * sigmoidf_(g1)));
            }
        }
    }
}

__device__ __forceinline__ void phase_final(const Params& P, const Ctx& C) {
    const int gw = C.vcu * 8 + C.wave, NGW = C.G * 8;
    const float* gpo = P.in[I_GPOST];
    for (int m = gw; m < NTOK; m += NGW) {
        const int b = m >> 13;
        const float rstd = rsqrtf(C.ROWSQ[m] * (1.f / DM) + RMS_EPS);
        const f32x4* xr = (const f32x4*)(P.in[I_X] + (size_t)m * DM) + C.lane; f32x4* zr = (f32x4*)(P.out + (size_t)m * DM) + C.lane;
#pragma unroll
        for (int j = 0; j < 4; ++j) { const int idx = (C.lane + 64 * j) * 4;
            const f32x4 g = *(const f32x4*)(gpo + idx), gt = *(const f32x4*)(C.MOD + b * 3072 + 2048 + idx);
            zr[64 * j] = xr[64 * j] + gt * (zr[64 * j] * rstd * g); }
    }
}

__global__ void __launch_bounds__(NTHR, 2) fwd_kernel(Params P) {
    extern __shared__ __attribute__((aligned(16))) unsigned char lds[];
    cg::grid_group grid = cg::this_grid();
    Ctx C;
    C.lds = lds; C.tid = threadIdx.x; C.lane = C.tid & 63; C.wave = __builtin_amdgcn_readfirstlane(C.tid >> 6);
    C.G = gridDim.x; { const int bx = blockIdx.x; C.vcu = (C.G % 8 == 0) ? (bx % 8) * (C.G / 8) + bx / 8 : bx; }
    unsigned char* ws = P.ws;
    C.ROWSQ = (float*)(ws + WS_ROWSQ); C.MOD = (float*)(ws + WS_MOD);
    C.WIN = (bf16_t*)(ws + WS_WIN); C.WAB = (bf16_t*)(ws + WS_WAB); C.WOUT = (bf16_t*)(ws + WS_WOUT);
    C.XN = (bf16_t*)(ws + WS_XN); C.OAB = C.XN; C.PROJ = (bf16_t*)(ws + WS_PROJ);
    C.OARAW = P.out; C.OB4 = (bf16_t*)((unsigned char*)P.out + 128 * MiB);

#define FRESH() do { int t_ = threadIdx.x; asm volatile("" : "+v"(t_)); C.tid = t_; C.lane = t_ & 63; C.wave = __builtin_amdgcn_readfirstlane(t_ >> 6); } while (0)
    phase_prologue(P, C);
    grid.sync(); FRESH();
    phase_prenorm(P, C);
    grid.sync(); FRESH();
    { pg8::Gemm g{C.XN, C.WIN, NTOK, NIN, DM, DM, DM}; pg8::StaticOrder S; S.init(NTOK, NIN, C.G, (int)blockIdx.x); EpiProj2 E{C.PROJ};
      pg8::gemm_phase<EpiProj2, pg8::StaticOrder, true, true>((PG8_LAS unsigned char*)lds, g, S, E); }
    grid.sync(); FRESH();
    phase_hgrn_naive(P, C);
    __syncthreads(); FRESH();
    phase_attn(C);
    grid.sync(); FRESH();
    phase_branch_norm(P, C);
    grid.sync(); FRESH();
    { pg8::Gemm g{C.OAB, C.WAB, NTOK, DM, DM, DM, DM}; pg8::StaticOrder S; S.init(NTOK, DM, C.G, (int)blockIdx.x); EpiMerge2 E{C.PROJ, C.PROJ};
      pg8::gemm_phase<EpiMerge2, pg8::StaticOrder, true, true>((PG8_LAS unsigned char*)lds, g, S, E); }
    grid.sync(); FRESH();
    { pg8::Gemm g{C.PROJ, C.WOUT, NTOK, DM, DM, NIN, DM}; pg8::StaticOrder S; S.init(NTOK, DM, C.G, (int)blockIdx.x); EpiZ2 E{P.out, C.ROWSQ};
      pg8::gemm_phase<EpiZ2, pg8::StaticOrder, true, true>((PG8_LAS unsigned char*)lds, g, S, E); }
    grid.sync(); FRESH();
    phase_final(P, C);
}

extern "C" void kernel_launch(void* const* d_in, const int* in_sizes, int n_in, void* d_out, int out_size, void* d_ws, size_t ws_size, hipStream_t stream) {
    static int grid = 0;
    if (grid == 0) {
        if (n_in != 17 || out_size != NTOK * DM || ws_size < WS_END) { fprintf(stderr, "kernel_launch: unexpected shapes (n_in %d out %d ws %zu)\n", n_in, out_size, ws_size); grid = -1; return; }
        int dev = 0, cus = 0, per_cu = 0;
        hipGetDevice(&dev); hipDeviceGetAttribute(&cus, hipDeviceAttributeMultiprocessorCount, dev);
        hipFuncSetAttribute((const void*)fwd_kernel, hipFuncAttributeMaxDynamicSharedMemorySize, LDS_BYTES);
        hipOccupancyMaxActiveBlocksPerMultiprocessor(&per_cu, (const void*)fwd_kernel, NTHR, LDS_BYTES);
        if (per_cu < 1) { fprintf(stderr, "kernel_launch: occupancy query says %d blocks per CU\n", per_cu); per_cu = 1; }
        grid = cus * 1;
        (void)hipGetLastError();
    }
    if (grid < 0) return;
    Params p{};
    for (int i = 0; i < 17; ++i) p.in[i] = (const float*)d_in[i];
    p.out = (float*)d_out; p.ws = (unsigned char*)d_ws;
    void* args[] = {&p};
    hipError_t e = hipLaunchCooperativeKernel((const void*)fwd_kernel, dim3(grid), dim3(NTHR), args, LDS_BYTES, stream);
    if (e != hipSuccess) fprintf(stderr, "cooperative launch failed: %s (grid %d)\n", hipGetErrorString(e), grid);
}
```

```cpp
#include <hip/hip_runtime.h>
#include <hip/hip_cooperative_groups.h>
#include <cstdio>
#include <cstdint>
namespace cg = cooperative_groups;
namespace pg8 {
#define PG8_LAS __attribute__((address_space(3)))
typedef unsigned short bf16_t;
typedef short bf16x8 __attribute__((ext_vector_type(8)));
typedef float f32x4 __attribute__((ext_vector_type(4)));
typedef unsigned u32x4 __attribute__((ext_vector_type(4)));
constexpr int BM = 256, BK = 64, HALF = 128, HTB = HALF * BK * 2  , STAGE_BYTES = 8 * HTB, NXCD = 8, WGM = 8;

__host__ __device__ __forceinline__ int lds_byte(int r, int c) { const int st = (r >> 4) * 2 + (c >> 5), rr = r & 15, cc = c & 31, ob = rr * 64 + cc * 2; return st * 1024 + (ob ^ (((ob >> 9) & 1) << 5)); }
__host__ __device__ __forceinline__ void stage_rc(int b, int& R, int& C) { const int st = b / 1024, sb = b % 1024, swz = sb ^ (((sb >> 9) & 1) << 5); R = (st >> 1) * 16 + swz / 64; C = (st & 1) * 32 + (swz % 64) / 2; }
__host__ __device__ __forceinline__ int perm32(int rho) { const int n = rho >> 4, i = rho & 15; return 8 * (i >> 2) + 4 * n + (i & 3); }

struct Unit { int pm, pn; };
struct Gemm { const bf16_t* A; const bf16_t* Bt; int M, N, K, lda, ldb; };

struct StaticOrder {
    int nM, nN, nwg, G, c;
    __host__ __device__ void init(int M, int N, int G_, int c_) { nM = M / BM; nN = N / BM; nwg = nM * nN; G = G_; c = c_; }
    __host__ __device__ bool next(int i, Unit& u) const {
        const long L = (long)i * G + c; if (L >= nwg) return false;
        int wgid = (int)L; { const int q = nwg / NXCD, r = nwg % NXCD, xcd = wgid % NXCD, off = wgid / NXCD; wgid = (xcd < r ? xcd * (q + 1) : r * (q + 1) + (xcd - r) * q) + off; }
        const int nig = WGM * nN, gid = wgid / nig, fm = gid * WGM, gsz = (nM - fm) < WGM ? (nM - fm) : WGM;
        u.pm = fm + ((wgid % nig) % gsz); u.pn = (wgid % nig) / gsz; return true;
    }
    __device__ __forceinline__ void a_ready(const Unit&) const {}
    __device__ __forceinline__ void done(const Unit&) const {}
};

__device__ __forceinline__ unsigned cvt_pk_bf16(float lo, float hi) { unsigned r; asm volatile("v_cvt_pk_bf16_f32 %0, %1, %2" : "=v"(r) : "v"(lo), "v"(hi)); return r; }
typedef float f32x2 __attribute__((ext_vector_type(2)));
template <class Epi, class Sched, bool ALIGN_EPI = false, bool SP2 = false>
__device__ __forceinline__ void gemm_phase(PG8_LAS unsigned char* lds, const Gemm g, const Sched& S, const Epi& E) {
    int tid_ = threadIdx.x; asm volatile("" : "+v"(tid_));
    const int tid = tid_, wid = __builtin_amdgcn_readfirstlane(tid >> 6), lane = tid & 63, wr = wid >> 2, wc = wid & 3, fr = lane & 15, fq = lane >> 4;
    const int K = g.K, nt = K / BK;
    unsigned voffA[2], voffB[2];
#pragma unroll
    for (int i = 0; i < 2; ++i) { int R, C; stage_rc(tid * 16 + i * 8192, R, C); const int Rb = Epi::PERM ? ((R & ~31) + perm32(R & 31)) : R;
        voffA[i] = (unsigned)(R * g.lda + C) * 2u; voffB[i] = (unsigned)(Rb * g.ldb + C) * 2u; }
    const size_t kstep = (size_t)(BK * 2);
    const size_t hstepA = (size_t)HALF * g.lda * 2, hstepB = (size_t)HALF * g.ldb * 2;
    const size_t tstepA = 2 * hstepA, tstepB = 2 * hstepB;
    const unsigned ldsw = (unsigned)wid * 1024u;
    const int aoff = lds_byte(wr * 64 + fr, fq * 8), boff = lds_byte(wc * 32 + fr, fq * 8);
#define PG8_SA(b, h) (((b) * 2 + (h)) * HTB)
#define PG8_SB(b, h) ((4 + (b) * 2 + (h)) * HTB)
#define PG8_STAGE(bufoff, gbase, voff) do { _Pragma("unroll") for (int _i = 0; _i < 2; ++_i) \
        __builtin_amdgcn_global_load_lds((const unsigned*)((const char*)(gbase) + (voff)[_i]), (PG8_LAS unsigned*)(lds + (bufoff) + ldsw + _i * 8192), 16, 0, 0); } while (0)
#define PG8_LDA(dst, b, h) do { _Pragma("unroll") for (int m = 0; m < 4; ++m) _Pragma("unroll") for (int k = 0; k < 2; ++k) dst[m][k] = *(const PG8_LAS bf16x8*)(lds + PG8_SA(b, h) + aoff + m * 2048 + k * 1024); } while (0)
#define PG8_LDB(dst, b, h) do { _Pragma("unroll") for (int n = 0; n < 2; ++n) _Pragma("unroll") for (int k = 0; k < 2; ++k) dst[n][k] = *(const PG8_LAS bf16x8*)(lds + PG8_SB(b, h) + boff + n * 2048 + k * 1024); } while (0)
#define PG8_MMA(ai, bj, At, Bt) do { __builtin_amdgcn_s_setprio(1); _Pragma("unroll") for (int m = 0; m < 4; ++m) _Pragma("unroll") for (int n = 0; n < 2; ++n) _Pragma("unroll") for (int k = 0; k < 2; ++k) \
        acc[ai][bj][m][n] = __builtin_amdgcn_mfma_f32_16x16x32_bf16(Bt[n][k], At[m][k], acc[ai][bj][m][n], 0, 0, 0); __builtin_amdgcn_s_setprio(0); } while (0)
#define PG8_WAIT_V(n) asm volatile("s_waitcnt vmcnt(" #n ")" ::: "memory")
#define PG8_WAIT_L(n) asm volatile("s_waitcnt lgkmcnt(" #n ")" ::: "memory")
#define PG8_BAR __builtin_amdgcn_s_barrier()
#define PG8_SCHED __builtin_amdgcn_sched_barrier(0)
    Unit cur, nxt; int ui = 0;
    if (!S.next(0, cur)) return;
    f32x4 acc[2][2][4][2];
#pragma unroll
    for (int a = 0; a < 2; ++a)
#pragma unroll
        for (int b = 0; b < 2; ++b)
#pragma unroll
            for (int m = 0; m < 4; ++m)
#pragma unroll
                for (int n = 0; n < 2; ++n) acc[a][b][m][n] = (f32x4){0.f, 0.f, 0.f, 0.f};
    bf16x8 At[4][2], B0[2][2], B1[2][2];
    const char* cA = (const char*)g.A + (size_t)cur.pm * tstepA; const char* cB = (const char*)g.Bt + (size_t)cur.pn * tstepB;
    S.a_ready(cur);
    if constexpr (SP2) {
        PG8_STAGE(PG8_SB(0, 0), cB, voffB); PG8_STAGE(PG8_SB(0, 1), cB + hstepB, voffB); PG8_STAGE(PG8_SA(0, 0), cA, voffA); PG8_STAGE(PG8_SA(0, 1), cA + hstepA, voffA);
        if (wr == 1) PG8_BAR;
        PG8_WAIT_V(2); PG8_BAR;
        PG8_STAGE(PG8_SB(1, 0), cB + kstep, voffB); PG8_STAGE(PG8_SA(1, 0), cA + kstep, voffA); PG8_STAGE(PG8_SB(1, 1), cB + hstepB + kstep, voffB);
        PG8_WAIT_V(6); PG8_BAR;
    } else {
        PG8_STAGE(PG8_SB(0, 0), cB, voffB); PG8_STAGE(PG8_SA(0, 0), cA, voffA); PG8_STAGE(PG8_SB(0, 1), cB + hstepB, voffB); PG8_STAGE(PG8_SA(0, 1), cA + hstepA, voffA);
        if (wr == 1) PG8_BAR;
        PG8_WAIT_V(4); PG8_BAR;
        PG8_STAGE(PG8_SB(1, 0), cB + kstep, voffB); PG8_STAGE(PG8_SA(1, 0), cA + kstep, voffA); PG8_STAGE(PG8_SB(1, 1), cB + hstepB + kstep, voffB);
        PG8_WAIT_V(6); PG8_BAR;
    }
    for (;;) {
        const bool has_next = S.next(ui + 1, nxt);
        const char* nA = has_next ? (const char*)g.A + (size_t)nxt.pm * tstepA : cA; const char* nB = has_next ? (const char*)g.Bt + (size_t)nxt.pn * tstepB : cB;
        for (int t = 0; t < nt; t += 2) {
            const bool last = (t == nt - 2);
            const char* a1 = cA + (size_t)(t + 1) * kstep;
            const char* a2 = last ? nA : cA + (size_t)(t + 2) * kstep; const char* b2 = last ? nB : cB + (size_t)(t + 2) * kstep;
            const char* a3 = a2 + kstep; const char* b3 = b2 + kstep;
            if (last && has_next) S.a_ready(nxt);
            if constexpr (Epi::MID) { if (t == nt / 2) E.mid(acc, cur, wr, wc, fr, fq); }
            if constexpr (SP2) {
            PG8_LDB(B0, 0, 0); PG8_LDB(B1, 0, 1); PG8_SCHED; PG8_LDA(At, 0, 0); PG8_STAGE(PG8_SA(1, 1), a1 + hstepA, voffA);
            PG8_WAIT_V(8); PG8_WAIT_L(0); PG8_BAR; PG8_MMA(0, 0, At, B0); PG8_MMA(0, 1, At, B1); PG8_BAR; PG8_SCHED;
            PG8_LDA(At, 0, 1); PG8_STAGE(PG8_SB(0, 0), b2, voffB); PG8_STAGE(PG8_SB(0, 1), b2 + hstepB, voffB); PG8_STAGE(PG8_SA(0, 0), a2, voffA);
            PG8_WAIT_V(8); PG8_WAIT_L(0); PG8_BAR; PG8_MMA(1, 0, At, B0); PG8_MMA(1, 1, At, B1); PG8_BAR; PG8_SCHED;
            PG8_LDB(B0, 1, 0); PG8_LDB(B1, 1, 1); PG8_SCHED; PG8_LDA(At, 1, 0); PG8_STAGE(PG8_SA(0, 1), a2 + hstepA, voffA);
            PG8_WAIT_V(8); PG8_WAIT_L(0); PG8_BAR; PG8_MMA(0, 0, At, B0); PG8_MMA(0, 1, At, B1); PG8_BAR; PG8_SCHED;
            PG8_LDA(At, 1, 1); PG8_STAGE(PG8_SB(1, 0), b3, voffB); PG8_STAGE(PG8_SB(1, 1), b3 + hstepB, voffB); PG8_STAGE(PG8_SA(1, 0), a3, voffA);
            PG8_WAIT_V(8); PG8_WAIT_L(0); PG8_BAR; PG8_MMA(1, 0, At, B0); PG8_MMA(1, 1, At, B1); PG8_BAR; PG8_SCHED;
            } else {
            PG8_LDB(B0, 0, 0); PG8_SCHED; PG8_LDA(At, 0, 0); PG8_STAGE(PG8_SA(1, 1), a1 + hstepA, voffA);
            PG8_WAIT_L(8); PG8_BAR; PG8_WAIT_L(0); PG8_MMA(0, 0, At, B0); PG8_BAR; PG8_SCHED;
            PG8_LDB(B1, 0, 1); PG8_STAGE(PG8_SB(0, 0), b2, voffB);
            PG8_BAR; PG8_WAIT_L(0); PG8_MMA(0, 1, At, B1); PG8_BAR;
            PG8_LDA(At, 0, 1); PG8_STAGE(PG8_SA(0, 0), a2, voffA);
            PG8_BAR; PG8_WAIT_L(0); PG8_MMA(1, 0, At, B0); PG8_BAR; PG8_SCHED;
            PG8_STAGE(PG8_SB(0, 1), b2 + hstepB, voffB);
            PG8_WAIT_V(6); PG8_BAR; PG8_MMA(1, 1, At, B1); PG8_BAR;
            PG8_LDB(B0, 1, 0); PG8_SCHED; PG8_LDA(At, 1, 0); PG8_STAGE(PG8_SA(0, 1), a2 + hstepA, voffA);
            PG8_WAIT_L(8); PG8_BAR; PG8_WAIT_L(0); PG8_MMA(0, 0, At, B0); PG8_BAR; PG8_SCHED;
            PG8_LDB(B1, 1, 1); PG8_STAGE(PG8_SB(1, 0), b3, voffB);
            PG8_BAR; PG8_WAIT_L(0); PG8_MMA(0, 1, At, B1); PG8_BAR;
            PG8_LDA(At, 1, 1); PG8_STAGE(PG8_SA(1, 0), a3, voffA);
            PG8_BAR; PG8_WAIT_L(0); PG8_MMA(1, 0, At, B0); PG8_BAR; PG8_SCHED;
            PG8_STAGE(PG8_SB(1, 1), b3 + hstepB, voffB);
            PG8_WAIT_V(6); PG8_BAR; PG8_MMA(1, 1, At, B1); PG8_BAR;
            }
        }
        if constexpr (ALIGN_EPI) { if (wr == 0) PG8_BAR; }
        if constexpr (!Epi::AFTER_DRAIN) { E(acc, cur, wr, wc, fr, fq); S.done(cur); }
        if (!has_next) break;
#pragma unroll
        for (int a = 0; a < 2; ++a)
#pragma unroll
            for (int b = 0; b < 2; ++b)
#pragma unroll
                for (int m = 0; m < 4; ++m)
#pragma unroll
                    for (int n = 0; n < 2; ++n) acc[a][b][m][n] = (f32x4){0.f, 0.f, 0.f, 0.f};
        cur = nxt; cA = nA; cB = nB; ++ui;
        if constexpr (ALIGN_EPI) { if (wr == 1) PG8_BAR; }
    }
    PG8_WAIT_V(0);
    if constexpr (!ALIGN_EPI) { if (wr == 0) PG8_BAR; }
    PG8_BAR;
    if constexpr (Epi::AFTER_DRAIN) { E.fused(acc, cur, wr, wc, fr, fq, lds, wid, lane); S.done(cur); }
#undef PG8_SA
#undef PG8_SB
#undef PG8_STAGE
#undef PG8_LDA
#undef PG8_LDB
#undef PG8_MMA
#undef PG8_WAIT_V
#undef PG8_WAIT_L
#undef PG8_BAR
#undef PG8_SCHED
}
}
#include <hip/hip_bf16.h>
#include <cmath>
namespace attn_body {
using bf16=__hip_bfloat16;
using bf16x8=__attribute__((ext_vector_type(8)))short;
using s16x4=__attribute__((ext_vector_type(4)))short;
using f32x16=__attribute__((ext_vector_type(16)))float;
using u32x4=__attribute__((ext_vector_type(4)))unsigned;
constexpr int SEQ=8192,D=64,PIN=6144,PO=1024;
constexpr int NW=8,QBLK=32,QB=QBLK*NW,KVBLK=64,NQB=SEQ/QB;
constexpr int ATTN_UNIT_ROWS=QB;
__device__ __forceinline__ int crow(int r,int hi){return (r&3)+8*(r>>2)+4*hi;}
#define SBAR() __builtin_amdgcn_sched_barrier(0)
__device__ __forceinline__ void cmask(f32x16&p0,f32x16&p1,int jb,int qrel,int hi){
  const float NEG=-INFINITY; int kb=64*jb+4*hi;
  #pragma unroll
  for(int r=0;r<16;++r){int kv=kb+(r&3)+8*(r>>2); if(kv>qrel)p0[r]=NEG; if(kv+32>qrel)p1[r]=NEG;}
}

constexpr int NSLOT=3, SLOTB=8192;
constexpr int LDS_K=0, LDS_V=NSLOT*SLOTB, LDS_WS=2*NSLOT*SLOTB, LDS_OST=LDS_WS+NW*64*4, LDS_BYTES=LDS_OST+NW*4096;
constexpr float C2=0.125f*1.4426950408889634f;
__device__ __forceinline__ void glds16(const void*gsrc,unsigned lds_dst){unsigned keep;
  asm volatile("s_mov_b32 %0, m0\n\ts_mov_b32 m0, %2\n\ts_nop 0\n\tglobal_load_lds_dwordx4 %1, off\n\ts_mov_b32 m0, %0":"=&s"(keep):"v"(gsrc),"s"(lds_dst):"memory");}
__device__ __forceinline__ float max3f(float a,float b,float c){float r;asm("v_max3_f32 %0, %1, %2, %3":"=v"(r):"v"(a),"v"(b),"v"(c));return r;}
__device__ __forceinline__ float max2f(float a,float b){float r;asm("v_max_f32_e32 %0, %1, %2":"=v"(r):"v"(a),"v"(b));return r;}
__device__ __forceinline__ float fadd_s(float a,float b){float r;asm("v_add_f32_e32 %0, %1, %2":"=v"(r):"v"(a),"v"(b));return r;}
__device__ __forceinline__ float fsub_s(float a,float b){float r;asm("v_sub_f32_e32 %0, %1, %2":"=v"(r):"v"(a),"v"(b));return r;}
typedef float f32x2_t __attribute__((ext_vector_type(2))); typedef __bf16 bf16x2_t __attribute__((ext_vector_type(2)));
__device__ __forceinline__ unsigned cvtpk_s(float lo,float hi){f32x2_t v={lo,hi};bf16x2_t b=__builtin_convertvector(v,bf16x2_t);return __builtin_bit_cast(unsigned,b);}
#define WAIT_BAR(N) asm volatile("s_waitcnt vmcnt(" #N ") lgkmcnt(0)\n\ts_barrier":::"memory")

__device__ __forceinline__ void qkt(f32x16&p0,f32x16&p1,const char*Kslot,const bf16x8*qr,const f32x16&negm,int r32,int hi){
  const char*kb=Kslot+hi*1024+r32*16;
  #pragma unroll
  for(int d0=0;d0<4;++d0){
    const bf16x8 b0=*reinterpret_cast<const bf16x8*>(kb+d0*2048);
    const bf16x8 b1=*reinterpret_cast<const bf16x8*>(kb+d0*2048+512);
    if(d0==0){p0=__builtin_amdgcn_mfma_f32_32x32x16_bf16(b0,qr[0],negm,0,0,0);p1=__builtin_amdgcn_mfma_f32_32x32x16_bf16(b1,qr[0],negm,0,0,0);}
    else{p0=__builtin_amdgcn_mfma_f32_32x32x16_bf16(b0,qr[d0],p0,0,0,0);p1=__builtin_amdgcn_mfma_f32_32x32x16_bf16(b1,qr[d0],p1,0,0,0);}}
}
typedef __attribute__((address_space(3))) const char* lds_cptr;
typedef short v4i16_t __attribute__((ext_vector_type(4)));
__device__ __forceinline__ void kload8(bf16x8*kf,lds_cptr kp){
  kf[0]=*(const __attribute__((address_space(3))) bf16x8*)(kp);      kf[1]=*(const __attribute__((address_space(3))) bf16x8*)(kp+512);
  kf[2]=*(const __attribute__((address_space(3))) bf16x8*)(kp+2048); kf[3]=*(const __attribute__((address_space(3))) bf16x8*)(kp+2560);
  kf[4]=*(const __attribute__((address_space(3))) bf16x8*)(kp+4096); kf[5]=*(const __attribute__((address_space(3))) bf16x8*)(kp+4608);
  kf[6]=*(const __attribute__((address_space(3))) bf16x8*)(kp+6144); kf[7]=*(const __attribute__((address_space(3))) bf16x8*)(kp+6656);
}
__device__ __forceinline__ void kload2(bf16x8*kf,lds_cptr kp,int j){ kf[2*j]=*(const __attribute__((address_space(3))) bf16x8*)(kp+j*2048); kf[2*j+1]=*(const __attribute__((address_space(3))) bf16x8*)(kp+j*2048+512); }
__device__ __forceinline__ s16x4 vtr(lds_cptr p){ return __builtin_bit_cast(s16x4,__builtin_amdgcn_ds_read_tr16_b64_v4i16((__attribute__((address_space(3))) v4i16_t*)p)); }
__device__ __forceinline__ float rowmax(const f32x16&p0,const f32x16&p1){
  float a=max3f(p0[0],p0[1],p1[0]),b=max3f(p0[2],p0[3],p1[1]);a=max3f(a,p1[2],p1[3]);
  #pragma unroll
  for(int r=4;r<16;r+=4){a=max3f(a,p0[r],p0[r+1]);b=max3f(b,p0[r+2],p0[r+3]);a=max3f(a,p1[r],p1[r+1]);b=max3f(b,p1[r+2],p1[r+3]);}
  const float m=max2f(a,b);
  auto rr=__builtin_amdgcn_permlane32_swap(__float_as_uint(m),__float_as_uint(m),false,false);
  return max2f(__uint_as_float(rr[0]),__uint_as_float(rr[1]));
}
__device__ __forceinline__ void pv(f32x16*o,int vb,bf16x8 pa0,bf16x8 pa1,bf16x8 pa2,bf16x8 pa3){
  #pragma unroll
  for(int d0=0;d0<2;++d0){s16x4 lo[4],hi[4];
    #pragma unroll
    for(int ks=0;ks<4;++ks){
      asm volatile("ds_read_b64_tr_b16 %0,%1 offset:%c2":"=&v"(lo[ks]):"v"(vb),"i"(d0*4096+ks*1024):"memory");
      asm volatile("ds_read_b64_tr_b16 %0,%1 offset:%c2":"=&v"(hi[ks]):"v"(vb),"i"(d0*4096+ks*1024+512):"memory");}
    asm volatile("s_waitcnt lgkmcnt(0)":::"memory");SBAR();
    #define PK(k) (bf16x8){lo[k][0],lo[k][1],lo[k][2],lo[k][3],hi[k][0],hi[k][1],hi[k][2],hi[k][3]}
    o[d0]=__builtin_amdgcn_mfma_f32_32x32x16_bf16(pa0,PK(0),o[d0],0,0,0);
    o[d0]=__builtin_amdgcn_mfma_f32_32x32x16_bf16(pa1,PK(1),o[d0],0,0,0);
    o[d0]=__builtin_amdgcn_mfma_f32_32x32x16_bf16(pa2,PK(2),o[d0],0,0,0);
    o[d0]=__builtin_amdgcn_mfma_f32_32x32x16_bf16(pa3,PK(3),o[d0],0,0,0);
    #undef PK
  }
}

#ifndef ATTN_STORE16
#define ATTN_STORE16(p,v) (*(u32x4*)(p)=(v))
#endif
template<int THRL> __device__ __forceinline__ void attn_unit(int b,int h,int qb,const bf16*Q,const bf16*__restrict__ K,const bf16*__restrict__ V,bf16*O,char*shm){
  const int tid=threadIdx.x,lane=tid&63,r32=lane&31,hi=lane>>5; const int wid=__builtin_amdgcn_readfirstlane(tid>>6);
  const long rowbase=(long)b*SEQ; const int q0=qb*QB;
  const bf16*Qw=Q+(rowbase+q0+wid*QBLK)*PIN;
  const bf16*Kh=K+rowbase*PIN,*Vh=V+rowbase*PIN;
  const unsigned lds0=(unsigned)(uintptr_t)shm;
  float*wsf=(float*)(shm+LDS_WS)+wid*64;
  const bf16*ksrc=Kh+(long)lane*PIN+wid*8;
  const bf16*vsrc=Vh+(long)(16*(wid&3)+(lane>>2))*PIN+(wid>>2)*32+(lane&3)*8;
  const unsigned kdst=lds0+LDS_K+wid*1024, vdst=lds0+LDS_V+wid*1024;
  #define DMA_K(t,slot) glds16(ksrc+(long)(t)*KVBLK*PIN,(unsigned)__builtin_amdgcn_readfirstlane(kdst+(slot)))
  #define DMA_V(t,slot) glds16(vsrc+(long)(t)*KVBLK*PIN,(unsigned)__builtin_amdgcn_readfirstlane(vdst+(slot)))
  const int vb0=(int)(lds0+LDS_V)+((lane>>4)&1)*32+(lane&3)*8+(4*hi+((lane&15)>>2))*64;
  const char*Kbase=shm+LDS_K; bf16x8 kf[8];
  const lds_cptr shm3=(lds_cptr)shm; const lds_cptr kp0=shm3+LDS_K+hi*1024+r32*16; const lds_cptr vp0=shm3+LDS_V+((lane>>4)&1)*32+(lane&3)*8+(4*hi+((lane&15)>>2))*64;
  const int NT=(q0+QB)/KVBLK;
  DMA_K(0,0);DMA_V(0,0);DMA_K(1,SLOTB);
  bf16x8 qr[4];
  #pragma unroll
  for(int d0=0;d0<4;++d0)qr[d0]=*reinterpret_cast<const bf16x8*>(&Qw[(long)r32*PIN+d0*16+hi*8]);
  float mhat=0.f,l_reg=0.f;float zz_;asm volatile("v_mov_b32 %0, 0":"=v"(zz_));f32x16 o[2];_Pragma("unroll") for(int r=0;r<16;++r){o[0][r]=zz_;o[1][r]=zz_;}f32x16 negm;_Pragma("unroll") for(int r=0;r<16;++r)negm[r]=zz_;asm volatile("":"+v"(negm));
  const int qrel=wid*QBLK+r32;
  #define CMASK(P0,P1,t) do{int jb_=(t)-(NT-4); if(jb_>=0)cmask(P0,P1,jb_,qrel,hi);}while(0)
  bool resc=false;
  #define START(P0,P1) do{ const float rm=rowmax(P0,P1); resc=false; \
    { const float dl=rm; mhat=fadd_s(mhat,dl); \
      _Pragma("unroll") for(int r=0;r<16;++r){P0[r]=fsub_s(P0[r],dl);P1[r]=fsub_s(P1[r],dl);} \
      _Pragma("unroll") for(int r=0;r<16;++r)negm[r]=-mhat; asm volatile("":"+v"(negm)); } \
    _Pragma("unroll") for(int r=0;r<16;++r)P0[r]=__builtin_amdgcn_exp2f(P0[r]); }while(0)
  #define RESC() do{ if(resc){ asm volatile("s_waitcnt lgkmcnt(0)":::"memory"); \
      _Pragma("unroll") for(int d_=0;d_<2;++d_) _Pragma("unroll") for(int r=0;r<16;++r)o[d_][r]*=wsf[crow(r,hi)]; } }while(0)
  f32x16 pA0,pA1,pB0,pB1;
  int sl_prev=0,sl_cur=0,sl_next=SLOTB;
  #define ROT() do{sl_prev=sl_cur;sl_cur=sl_next;sl_next=(sl_next==(NSLOT-1)*SLOTB)?0:sl_next+SLOTB;}while(0)
  DMA_K(2,2*SLOTB);
  WAIT_BAR(3);
  qkt(pA0,pA1,Kbase,qr,negm,r32,hi);asm volatile("s_nop 15\n\ts_nop 7":"+v"(pA0),"+v"(pA1));CMASK(pA0,pA1,0);
  START(pA0,pA1);
  _Pragma("unroll") for(int r=0;r<16;++r)pA1[r]=__builtin_amdgcn_exp2f(pA1[r]);
  WAIT_BAR(0);
  DMA_K(3,0);DMA_V(1,SLOTB);
  ROT();
  kload8(kf,kp0+sl_cur);
  WAIT_BAR(2);
  s16x4 vlo[8],vhi[8]; u32x4 pw0,pw1,pw2,pw3;
  #define PKW(P,B) cvtpk_s(P[B],P[B+1])
  #define PAF(k) __builtin_bit_cast(bf16x8,pw##k)
  #define VFR(i) (bf16x8){vlo[i][0],vlo[i][1],vlo[i][2],vlo[i][3],vhi[i][0],vhi[i][1],vhi[i][2],vhi[i][3]}
  #define PIN(x) asm volatile("":"+v"(x))
  #define MX3(a,b,c) __builtin_fmaxf(__builtin_fmaxf((a),(b)),(c))
  #define GAPA(MF,A0,A1,A2,A3,W0,W1,PW) do{ MF; sacc+=A0; sacc+=A1; sacc+=A2; sacc+=A3; PIN(sacc); W0; W1; PIN(PW); SBAR(); }while(0)
  #define EX(v) __builtin_amdgcn_exp2f(v)
  #define GAPB(MF,X,B) do{ MF; X[B]=EX(X[B]); X[B+1]=EX(X[B+1]); X[B+2]=EX(X[B+2]); X[B+3]=EX(X[B+3]); PIN(X); SBAR(); }while(0)
  #define VRD(i) do{ vlo[i]=vtr(vp_+(((i)>>2)*4096+((i)&3)*1024)); vhi[i]=vtr(vp_+(((i)>>2)*4096+((i)&3)*1024+512)); }while(0)
  #define KRD(G,j) do{ if(G){ kload2(kf,kp0+sl_next,j); SBAR(); } }while(0)
  #define STEP(C0,C1,P0,P1,t,GK,GV,GL) do{ SBAR(); \
    const lds_cptr vp_=vp0+sl_prev; \
    VRD(0); SBAR(); float sacc=(P0[0]+P0[1]); \
    GAPA(C0=__builtin_amdgcn_mfma_f32_32x32x16_bf16(kf[0],qr[0],negm,0,0,0), P0[2],P0[3],P0[4],P0[5],     pw0[0]=PKW(P0,0), pw0[1]=PKW(P0,2), pw0); \
    VRD(4); SBAR(); GAPA(C1=__builtin_amdgcn_mfma_f32_32x32x16_bf16(kf[1],qr[0],negm,0,0,0), P0[6],P0[7],P0[8],P0[9],     pw0[2]=PKW(P0,4), pw0[3]=PKW(P0,6), pw0); \
    VRD(1); SBAR(); GAPA(C0=__builtin_amdgcn_mfma_f32_32x32x16_bf16(kf[2],qr[1],C0,0,0,0),   P0[10],P0[11],P0[12],P0[13], pw1[0]=PKW(P0,8), pw1[1]=PKW(P0,10), pw1); \
    VRD(5); SBAR(); GAPA(C1=__builtin_amdgcn_mfma_f32_32x32x16_bf16(kf[3],qr[1],C1,0,0,0),   P0[14],P0[15],P1[0],P1[1],   pw1[2]=PKW(P0,12),pw1[3]=PKW(P0,14), pw1); \
    VRD(2); SBAR(); GAPA(C0=__builtin_amdgcn_mfma_f32_32x32x16_bf16(kf[4],qr[2],C0,0,0,0),   P1[2],P1[3],P1[4],P1[5],     pw2[0]=PKW(P1,0), pw2[1]=PKW(P1,2), pw2); \
    VRD(6); SBAR(); GAPA(C1=__builtin_amdgcn_mfma_f32_32x32x16_bf16(kf[5],qr[2],C1,0,0,0),   P1[6],P1[7],P1[8],P1[9],     pw2[2]=PKW(P1,4), pw2[3]=PKW(P1,6), pw2); \
    VRD(3); SBAR(); GAPA(C0=__builtin_amdgcn_mfma_f32_32x32x16_bf16(kf[6],qr[3],C0,0,0,0),   P1[10],P1[11],P1[12],P1[13], pw3[0]=PKW(P1,8), pw3[1]=PKW(P1,10), pw3); \
    VRD(7); SBAR(); GAPA(C1=__builtin_amdgcn_mfma_f32_32x32x16_bf16(kf[7],qr[3],C1,0,0,0),   P1[14],P1[15],0.f,0.f,       pw3[2]=PKW(P1,12),pw3[3]=PKW(P1,14), pw3); \
    l_reg+=sacc; \
    if(GK){DMA_K((t)+3,sl_cur);} if(GV){DMA_V((t)+1,sl_next);} \
    CMASK(C0,C1,t); \
    { float a=MX3(C0[0],C0[1],C1[0]),b=MX3(C0[2],C0[3],C1[1]); a=MX3(a,C1[2],C1[3]); \
      _Pragma("unroll") for(int r=4;r<16;r+=4){a=MX3(a,C0[r],C0[r+1]);b=MX3(b,C0[r+2],C0[r+3]);a=MX3(a,C1[r],C1[r+1]);b=MX3(b,C1[r+2],C1[r+3]);} \
      float rm=__builtin_fmaxf(a,b); { auto rr=__builtin_amdgcn_permlane32_swap(__float_as_uint(rm),__float_as_uint(rm),false,false); rm=__builtin_fmaxf(__uint_as_float(rr[0]),__uint_as_float(rr[1])); } \
      resc=false; \
      if(__builtin_expect(__any(rm>(float)THRL),0)){ const float dl=__builtin_fmaxf(rm,0.f); mhat+=dl; \
        _Pragma("unroll") for(int r=0;r<16;++r){C0[r]-=dl;C1[r]-=dl;} \
        _Pragma("unroll") for(int r=0;r<16;++r)negm[r]=-mhat; asm volatile("":"+v"(negm)); \
        const float f=__builtin_amdgcn_exp2f(-dl); l_reg*=f; if(hi==0)wsf[r32]=f; resc=true; } } \
    SBAR(); \
    GAPB(o[0]=__builtin_amdgcn_mfma_f32_32x32x16_bf16(PAF(0),VFR(0),o[0],0,0,0), C0,0); \
    GAPB(o[1]=__builtin_amdgcn_mfma_f32_32x32x16_bf16(PAF(0),VFR(4),o[1],0,0,0), C0,4); \
    KRD(GL,0); GAPB(o[0]=__builtin_amdgcn_mfma_f32_32x32x16_bf16(PAF(1),VFR(1),o[0],0,0,0), C0,8); \
    KRD(GL,1); GAPB(o[1]=__builtin_amdgcn_mfma_f32_32x32x16_bf16(PAF(1),VFR(5),o[1],0,0,0), C0,12); \
    KRD(GL,2); GAPB(o[0]=__builtin_amdgcn_mfma_f32_32x32x16_bf16(PAF(2),VFR(2),o[0],0,0,0), C1,0); \
    KRD(GL,3); GAPB(o[1]=__builtin_amdgcn_mfma_f32_32x32x16_bf16(PAF(2),VFR(6),o[1],0,0,0), C1,4); \
    GAPB(o[0]=__builtin_amdgcn_mfma_f32_32x32x16_bf16(PAF(3),VFR(3),o[0],0,0,0), C1,8); \
    GAPB(o[1]=__builtin_amdgcn_mfma_f32_32x32x16_bf16(PAF(3),VFR(7),o[1],0,0,0), C1,12); \
    }while(0)
  int t=1;
  #undef CMASK
  #define CMASK(P0,P1,t) do{}while(0)
  for(;t+5<NT;t+=2){
    STEP(pB0,pB1,pA0,pA1,t,true,true,true);     WAIT_BAR(2); RESC(); ROT();
    STEP(pA0,pA1,pB0,pB1,t+1,true,true,true);   WAIT_BAR(2); RESC(); ROT();
  }
  #undef CMASK
  #define CMASK(P0,P1,t) do{int jb_=(t)-(NT-4); if(jb_>=0)cmask(P0,P1,jb_,qrel,hi);}while(0)
  #define ENDW(tt) do{ if((tt)+3<NT){WAIT_BAR(2);} else if((tt)+2<NT){WAIT_BAR(1);} else {WAIT_BAR(0);} }while(0)
  for(;t+1<NT;t+=2){
    STEP(pB0,pB1,pA0,pA1,t,(t+3<NT),(t+1<NT),(t+1<NT));       ENDW(t);   RESC(); ROT();
    STEP(pA0,pA1,pB0,pB1,t+1,(t+4<NT),(t+2<NT),(t+2<NT));     ENDW(t+1); RESC(); ROT();
  }
  STEP(pB0,pB1,pA0,pA1,NT-1,false,false,false); RESC();
  { float sacc=pB0[0]+pB0[1]; _Pragma("unroll") for(int r=2;r<16;++r)sacc+=pB0[r]; _Pragma("unroll") for(int r=0;r<16;++r)sacc+=pB1[r]; l_reg+=sacc;
    pw0=(u32x4){PKW(pB0,0),PKW(pB0,2),PKW(pB0,4),PKW(pB0,6)};pw1=(u32x4){PKW(pB0,8),PKW(pB0,10),PKW(pB0,12),PKW(pB0,14)};pw2=(u32x4){PKW(pB1,0),PKW(pB1,2),PKW(pB1,4),PKW(pB1,6)};pw3=(u32x4){PKW(pB1,8),PKW(pB1,10),PKW(pB1,12),PKW(pB1,14)};
    SBAR(); pv(o,vb0+sl_cur,PAF(0),PAF(1),PAF(2),PAF(3)); }
  #undef PKW
  #undef PAF
  #undef VFR
  #undef PIN
  #undef MX3
  #undef GAPA
  #undef GAPB
  #undef EX
  #undef VRD
  #undef KRD
  #undef STEP
  #undef ENDW
  {auto rr=__builtin_amdgcn_permlane32_swap(__float_as_uint(l_reg),__float_as_uint(l_reg),false,false);l_reg=__uint_as_float(rr[0])+__uint_as_float(rr[1]);}
  if(hi==0)wsf[32+r32]=l_reg;asm volatile("s_waitcnt lgkmcnt(0)":::"memory");
  float rli[16];
  #pragma unroll
  for(int r=0;r<16;++r)rli[r]=__builtin_amdgcn_rcpf(wsf[32+crow(r,hi)]);
  bf16*Ow=O+(rowbase+q0+wid*QBLK)*PO;
  { bf16*stg=(bf16*)(shm+LDS_OST)+wid*2048;
    #pragma unroll
    for(int r=0;r<16;++r){const int orow=crow(r,hi);
      #pragma unroll
      for(int d0=0;d0<2;++d0)stg[orow*64+d0*32+r32]=__float2bfloat16(o[d0][r]*rli[r]);}
    asm volatile("s_waitcnt lgkmcnt(0)":::"memory");
    #pragma unroll
    for(int i=0;i<4;++i){const int row=i*8+(lane>>3),ch=lane&7; const u32x4 v=*(const u32x4*)(stg+row*64+ch*8); ATTN_STORE16(Ow+(long)row*PO+ch*8,v);} }
  asm volatile("s_waitcnt lgkmcnt(0)\n\ts_barrier":::"memory");
  #undef DMA_K
  #undef DMA_V
  #undef CMASK
  #undef START
  #undef RESC
  #undef ROT
}
constexpr int ATTN_LDS_BYTES=LDS_BYTES;
#undef SBAR
#undef WAIT_BAR
}
constexpr int DM = 1024, NB = 8, SEQ = 8192, NTOK = NB * SEQ, NIN = 6144;
constexpr int C_HQ = 0, C_HF = 512, C_HI = 1024, C_HG = 1536, C_DQ = 2048, C_DK = 2560, C_DV = 3072, C_DG = 3584, C_MA = 4096, C_MB = 5120;
constexpr float RMS_EPS = 1e-6f;
constexpr float QSCALE = 0.125f * 1.4426950408889634f;
constexpr float LAM_INIT = 0.2f;
constexpr size_t MiB = 1u << 20;
constexpr size_t WS_ROWSQ = 0, WS_QCTR = 256 * 1024, WS_MOD = 512 * 1024, WS_WIN = 1 * MiB, WS_WAB = 13 * MiB, WS_WOUT = 15 * MiB, WS_XN = 32 * MiB, WS_PROJ = 160 * MiB, WS_END = 928 * MiB;
constexpr int LDS_BYTES = 147456;
constexpr int NTHR = 512;

typedef unsigned short bf16_t;
typedef short bf16x8 __attribute__((ext_vector_type(8)));
typedef float f32x4 __attribute__((ext_vector_type(4)));
typedef float f32x2 __attribute__((ext_vector_type(2)));
typedef unsigned u32x4 __attribute__((ext_vector_type(4)));
typedef unsigned u32x2 __attribute__((ext_vector_type(2)));

__device__ __forceinline__ float bf2f(unsigned h) { return __uint_as_float(h << 16); }
__device__ __forceinline__ unsigned f2bf(float f) { unsigned u = __float_as_uint(f); return (u + 0x7fffu + ((u >> 16) & 1u)) >> 16; }
__device__ __forceinline__ unsigned pk2(float lo, float hi) { return f2bf(lo) | (f2bf(hi) << 16); }
__device__ __forceinline__ float wave_sum(float v) {
#pragma unroll
    for (int o = 1; o < 64; o <<= 1) v += __shfl_xor(v, o);
    return v;
}
__device__ __forceinline__ float sigmoidf_(float v) { return 1.0f / (1.0f + __expf(-v)); }

struct Params { const float* in[17]; float* out; unsigned char* ws; };
enum { I_X = 0, I_C, I_WADA, I_BADA, I_GPRE, I_GPOST, I_WIN, I_LB, I_HGG, I_LQ1, I_LK1, I_LQ2, I_LK2, I_DNG, I_WA, I_WB, I_WOUT };

struct Ctx {
    unsigned char* lds; int tid, lane, wave, vcu, G;
    bf16_t *WIN, *WAB, *WOUT, *XN, *PROJ, *OAB, *OB4;
    float *ROWSQ, *MOD, *OARAW;
};

__device__ __forceinline__ void transpose_item(const float* __restrict__ W, int N, bf16_t* WT, int ldt, int koff, float* scr, int item, int lane) {
    const int nblk = N / 32, kb = item / nblk, nb = item % nblk, k0 = 64 * kb, n0 = 32 * nb;
#pragma unroll 8
    for (int i = 0; i < 32; ++i) { const int kk = 2 * i + (lane >> 5); scr[kk * 33 + (lane & 31)] = W[(size_t)(k0 + kk) * N + n0 + (lane & 31)]; }
    asm volatile("s_waitcnt lgkmcnt(0)" ::: "memory");
    const int c = lane & 7;
#pragma unroll
    for (int j = 0; j < 4; ++j) { const int n = (lane >> 3) + 8 * j; const float* s = scr + (8 * c) * 33 + n;
        u32x4 o; o.x = pk2(s[0 * 33], s[1 * 33]); o.y = pk2(s[2 * 33], s[3 * 33]); o.z = pk2(s[4 * 33], s[5 * 33]); o.w = pk2(s[6 * 33], s[7 * 33]);
        *(u32x4*)(WT + (size_t)(n0 + n) * ldt + koff + k0 + 8 * c) = o; }
    asm volatile("s_waitcnt lgkmcnt(0)" ::: "memory");
}

__device__ __forceinline__ void phase_prologue(const Params& P, const Ctx& C) {
    if (C.vcu < 48) {
        float* sc = (float*)(C.lds + 69632); float* red = (float*)(C.lds + 102400);
        const float* cc = P.in[I_C];
        for (int i = C.tid; i < NB * DM; i += NTHR) { const float v = cc[i]; sc[i] = v * sigmoidf_(v); }
        __syncthreads();
        const int n = C.vcu * 64 + C.lane; const float* wa = P.in[I_WADA];
        float acc[NB];
#pragma unroll
        for (int b = 0; b < NB; ++b) acc[b] = 0.f;
#pragma unroll 4
        for (int kk = 0; kk < 128; ++kk) { const int k = C.wave * 128 + kk; const float w = wa[(size_t)k * 3072 + n];
#pragma unroll
            for (int b = 0; b < NB; ++b) acc[b] += sc[b * DM + k] * w; }
#pragma unroll
        for (int b = 0; b < NB; ++b) red[(C.wave * NB + b) * 64 + C.lane] = acc[b];
        __syncthreads();
        { const int bb = C.tid >> 6; float s = 0.f;
#pragma unroll
          for (int w = 0; w < 8; ++w) s += red[(w * NB + bb) * 64 + C.lane];
          C.MOD[bb * 3072 + n] = s + P.in[I_BADA][n]; }
        __syncthreads();
    }
    float* scr = (float*)(C.lds + C.wave * 8448);
    const int gw = C.vcu * 8 + C.wave, NGW = C.G * 8;
    constexpr int IT_IN = 16 * 192, IT_A = 8 * 32, IT_B = 8 * 32, IT_O = 16 * 32;
    for (int it = gw; it < IT_IN + IT_A + IT_B + IT_O; it += NGW) {
        int r = it;
        if (r < IT_IN) { transpose_item(P.in[I_WIN], NIN, C.WIN, DM, 0, scr, r, C.lane); continue; } r -= IT_IN;
        if (r < IT_A) { transpose_item(P.in[I_WA], DM, C.WAB, DM, 0, scr, r, C.lane); continue; } r -= IT_A;
        if (r < IT_B) { transpose_item(P.in[I_WB], DM, C.WAB, DM, 512, scr, r, C.lane); continue; } r -= IT_B;
        transpose_item(P.in[I_WOUT], DM, C.WOUT, DM, 0, scr, r, C.lane);
    }
    for (int i = C.vcu * NTHR + C.tid; i < NTOK; i += C.G * NTHR) C.ROWSQ[i] = 0.f;
    if (blockIdx.x == 0 && C.tid == 0) *(unsigned*)(P.ws + WS_QCTR) = 0u;
}

__device__ __forceinline__ void phase_prenorm(const Params& P, const Ctx& C) {
    const int gw = C.vcu * 8 + C.wave, NGW = C.G * 8;
    const float* gp = P.in[I_GPRE];
    for (int m = gw; m < NTOK; m += NGW) {
        const int b = m >> 13;
        const f32x4* xr = (const f32x4*)(P.in[I_X] + (size_t)m * DM) + C.lane;
        f32x4 v[4]; float s = 0.f;
#pragma unroll
        for (int j = 0; j < 4; ++j) { v[j] = xr[64 * j]; s += (v[j].x * v[j].x + v[j].y * v[j].y) + (v[j].z * v[j].z + v[j].w * v[j].w); }
        const float rstd = rsqrtf(wave_sum(s) * (1.f / DM) + RMS_EPS);
        u32x2* o8 = (u32x2*)(C.XN + (size_t)m * DM) + C.lane;
#pragma unroll
        for (int j = 0; j < 4; ++j) { const int idx = (C.lane + 64 * j) * 4;
            const f32x4 g = *(const f32x4*)(gp + idx), sh = *(const f32x4*)(C.MOD + b * 3072 + idx), sc = *(const f32x4*)(C.MOD + b * 3072 + 1024 + idx);
            const f32x4 h = v[j] * rstd * g * (sc + 1.0f) + sh;
            u32x2 o; o.x = pk2(h.x, h.y); o.y = pk2(h.z, h.w); o8[64 * j] = o; }
    }
}

template <class Epi>
__device__ __forceinline__ void gemm_simple(const bf16_t* __restrict__ A, int lda, const bf16_t* __restrict__ Bt, int ldb, int M, int N, int K, const Ctx& C, const Epi& E) {
    const int fr = C.lane & 15, fq = C.lane >> 4, wm = C.wave >> 2, wn = C.wave & 3;
    const int ntn = N / 256, ntiles = (M / 128) * ntn;
    for (int tile = C.vcu; tile < ntiles; tile += C.G) {
        const int tm = tile / ntn, tn = tile % ntn, m0 = tm * 128 + wm * 64, n0 = tn * 256 + wn * 64;
        f32x4 acc[4][4];
#pragma unroll
        for (int i = 0; i < 4; ++i)
#pragma unroll
            for (int j = 0; j < 4; ++j) acc[i][j] = (f32x4){0.f, 0.f, 0.f, 0.f};
        const bf16_t* ap = A + (size_t)(m0 + fr) * lda + fq * 8; const bf16_t* bp = Bt + (size_t)(n0 + fr) * ldb + fq * 8;
        for (int k0 = 0; k0 < K; k0 += 32) {
            if (Epi::MID) { if (k0 == K / 2) E.mid(acc, m0, n0, fr, fq); }
            bf16x8 a[4], b[4];
#pragma unroll
            for (int i = 0; i < 4; ++i) { a[i] = *(const bf16x8*)(ap + (size_t)i * 16 * lda + k0); b[i] = *(const bf16x8*)(bp + (size_t)i * 16 * ldb + k0); }
#pragma unroll
            for (int mi = 0; mi < 4; ++mi)
#pragma unroll
                for (int ni = 0; ni < 4; ++ni) acc[mi][ni] = __builtin_amdgcn_mfma_f32_16x16x32_bf16(b[ni], a[mi], acc[mi][ni], 0, 0, 0);
        }
        E(acc, m0, n0, fr, fq);
    }
}
struct EpiProj {
    static constexpr bool MID = false; bf16_t* O;
    __device__ __forceinline__ void mid(f32x4 (&)[4][4], int, int, int, int) const {}
    __device__ __forceinline__ void operator()(const f32x4 (&acc)[4][4], int m0, int n0, int fr, int fq) const {
        const float sc = (n0 >= C_DQ && n0 < C_DK) ? QSCALE : 1.0f;
#pragma unroll
        for (int mi = 0; mi < 4; ++mi)
#pragma unroll
            for (int ni = 0; ni < 4; ++ni) { const f32x4 v = acc[mi][ni] * sc; u32x2 o; o.x = pk2(v.x, v.y); o.y = pk2(v.z, v.w);
                *(u32x2*)(O + (size_t)(m0 + 16 * mi + fr) * NIN + n0 + 16 * ni + 4 * fq) = o; }
    }
};
struct EpiMerge {
    static constexpr bool MID = true; const bf16_t* PROJ; bf16_t* Y;
    __device__ __forceinline__ void mid(f32x4 (&acc)[4][4], int m0, int n0, int fr, int fq) const {
#pragma unroll
        for (int mi = 0; mi < 4; ++mi)
#pragma unroll
            for (int ni = 0; ni < 4; ++ni) { const bf16_t* p = PROJ + (size_t)(m0 + 16 * mi + fr) * NIN + n0 + 16 * ni + 4 * fq;
                const u32x2 a = *(const u32x2*)(p + C_MA), b = *(const u32x2*)(p + C_MB);
                const float a0 = bf2f(a.x & 0xffffu), a1 = bf2f(a.x >> 16), a2 = bf2f(a.y & 0xffffu), a3 = bf2f(a.y >> 16);
                const float b0 = bf2f(b.x & 0xffffu), b1 = bf2f(b.x >> 16), b2 = bf2f(b.y & 0xffffu), b3 = bf2f(b.y >> 16);
                f32x4 r; r.x = (1.f + __expf(-b0)) / (1.f + __expf(-a0)); r.y = (1.f + __expf(-b1)) / (1.f + __expf(-a1));
                r.z = (1.f + __expf(-b2)) / (1.f + __expf(-a2)); r.w = (1.f + __expf(-b3)) / (1.f + __expf(-a3));
                acc[mi][ni] = acc[mi][ni] * r; }
    }
    __device__ __forceinline__ void operator()(const f32x4 (&acc)[4][4], int m0, int n0, int fr, int fq) const {
#pragma unroll
        for (int mi = 0; mi < 4; ++mi)
#pragma unroll
            for (int ni = 0; ni < 4; ++ni) { const size_t off = (size_t)(m0 + 16 * mi + fr) * NIN + n0 + 16 * ni + 4 * fq;
                const u32x2 b = *(const u32x2*)(PROJ + off + C_MB);
                f32x4 s; s.x = sigmoidf_(bf2f(b.x & 0xffffu)); s.y = sigmoidf_(bf2f(b.x >> 16)); s.z = sigmoidf_(bf2f(b.y & 0xffffu)); s.w = sigmoidf_(bf2f(b.y >> 16));
                const f32x4 v = acc[mi][ni] * s; u32x2 o; o.x = pk2(v.x, v.y); o.y = pk2(v.z, v.w);
                *(u32x2*)(Y + off) = o; }
    }
};
struct EpiZ {
    static constexpr bool MID = false; float* Z; float* ROWSQ;
    __device__ __forceinline__ void mid(f32x4 (&)[4][4], int, int, int, int) const {}
    __device__ __forceinline__ void operator()(const f32x4 (&acc)[4][4], int m0, int n0, int fr, int fq) const {
#pragma unroll
        for (int mi = 0; mi < 4; ++mi) { float s = 0.f;
#pragma unroll
            for (int ni = 0; ni < 4; ++ni) { const f32x4 v = acc[mi][ni]; s += (v.x * v.x + v.y * v.y) + (v.z * v.z + v.w * v.w);
                *(f32x4*)(Z + (size_t)(m0 + 16 * mi + fr) * DM + n0 + 16 * ni + 4 * fq) = v; }
            s += __shfl_xor(s, 16); s += __shfl_xor(s, 32);
            if (fq == 0) atomicAdd(ROWSQ + m0 + 16 * mi + fr, s); }
    }
};


__device__ __forceinline__ unsigned cvtpk(float lo, float hi) { unsigned r; asm volatile("v_cvt_pk_bf16_f32 %0, %1, %2" : "=v"(r) : "v"(lo), "v"(hi)); return r; }
struct EpiProj2 {
    static constexpr bool PERM = true, AFTER_DRAIN = false, MID = false; bf16_t* O;
    __device__ __forceinline__ void mid(f32x4 (&)[2][2][4][2], const pg8::Unit&, int, int, int, int) const {}
    __device__ __forceinline__ void operator()(const f32x4 (&acc)[2][2][4][2], const pg8::Unit& u, int wr, int wc, int fr, int fq) const {
        const float sc = (u.pn == 8 || u.pn == 9) ? QSCALE : 1.0f;
        const int row0 = u.pm * 256 + wr * 64 + fr, col0 = u.pn * 256 + wc * 32 + 8 * fq;
#pragma unroll
        for (int ai = 0; ai < 2; ++ai)
#pragma unroll
            for (int m = 0; m < 4; ++m) { bf16_t* rowp = O + (size_t)(row0 + ai * 128 + m * 16) * NIN + col0;
#pragma unroll
                for (int bj = 0; bj < 2; ++bj) { const f32x4 v0 = acc[ai][bj][m][0] * sc, v1 = acc[ai][bj][m][1] * sc;
                    u32x4 w; w.x = cvtpk(v0[0], v0[1]); w.y = cvtpk(v0[2], v0[3]); w.z = cvtpk(v1[0], v1[1]); w.w = cvtpk(v1[2], v1[3]);
                    *(u32x4*)(rowp + bj * 128) = w; } }
    }
};
__device__ __forceinline__ void unpack8(const u32x4 a, float (&f)[8]) {
    f[0] = bf2f(a.x & 0xffffu); f[1] = bf2f(a.x >> 16); f[2] = bf2f(a.y & 0xffffu); f[3] = bf2f(a.y >> 16);
    f[4] = bf2f(a.z & 0xffffu); f[5] = bf2f(a.z >> 16); f[6] = bf2f(a.w & 0xffffu); f[7] = bf2f(a.w >> 16);
}
struct EpiMerge2 {
    static constexpr bool PERM = true, AFTER_DRAIN = false, MID = true; const bf16_t* PROJ; bf16_t* Y;
    __device__ __forceinline__ void mid(f32x4 (&acc)[2][2][4][2], const pg8::Unit& u, int wr, int wc, int fr, int fq) const {
        asm volatile("" : "+v"(fr), "+v"(fq));
        const int row0 = u.pm * 256 + wr * 64 + fr, col0 = u.pn * 256 + wc * 32 + 8 * fq;
#pragma unroll
        for (int ai = 0; ai < 2; ++ai)
#pragma unroll
            for (int m = 0; m < 4; ++m) { const bf16_t* rowp = PROJ + (size_t)(row0 + ai * 128 + m * 16) * NIN + col0;
#pragma unroll
                for (int bj = 0; bj < 2; ++bj) { float a[8], b[8]; unpack8(*(const u32x4*)(rowp + C_MA + bj * 128), a); unpack8(*(const u32x4*)(rowp + C_MB + bj * 128), b);
                    float r[8];
#pragma unroll
                    for (int i = 0; i < 8; ++i) r[i] = (1.f + __expf(-b[i])) * __builtin_amdgcn_rcpf(1.f + __expf(-a[i]));
                    acc[ai][bj][m][0] = acc[ai][bj][m][0] * (f32x4){r[0], r[1], r[2], r[3]}; acc[ai][bj][m][1] = acc[ai][bj][m][1] * (f32x4){r[4], r[5], r[6], r[7]}; }
                asm volatile("" : "+v"(acc[ai][0][m][0]), "+v"(acc[ai][0][m][1]), "+v"(acc[ai][1][m][0]), "+v"(acc[ai][1][m][1]) :: "memory"); }
    }
    __device__ __forceinline__ void operator()(const f32x4 (&acc)[2][2][4][2], const pg8::Unit& u, int wr, int wc, int fr, int fq) const {
        asm volatile("" : "+v"(fr), "+v"(fq));
        const int row0 = u.pm * 256 + wr * 64 + fr, col0 = u.pn * 256 + wc * 32 + 8 * fq;
#pragma unroll
        for (int ai = 0; ai < 2; ++ai)
#pragma unroll
            for (int m = 0; m < 4; ++m) { const size_t off = (size_t)(row0 + ai * 128 + m * 16) * NIN + col0;
#pragma unroll
                for (int bj = 0; bj < 2; ++bj) { float b[8]; unpack8(*(const u32x4*)(PROJ + off + C_MB + bj * 128), b);
#pragma unroll
                    for (int i = 0; i < 8; ++i) b[i] = __builtin_amdgcn_rcpf(1.f + __expf(-b[i]));
                    const f32x4 v0 = acc[ai][bj][m][0] * (f32x4){b[0], b[1], b[2], b[3]}, v1 = acc[ai][bj][m][1] * (f32x4){b[4], b[5], b[6], b[7]};
                    u32x4 w; w.x = cvtpk(v0[0], v0[1]); w.y = cvtpk(v0[2], v0[3]); w.z = cvtpk(v1[0], v1[1]); w.w = cvtpk(v1[2], v1[3]);
                    *(u32x4*)(Y + off + bj * 128) = w; }
                asm volatile("" ::: "memory"); }
    }
};
struct EpiZ2 {
    static constexpr bool PERM = false, AFTER_DRAIN = false, MID = false; float* Z; float* ROWSQ;
    __device__ __forceinline__ void mid(f32x4 (&)[2][2][4][2], const pg8::Unit&, int, int, int, int) const {}
    __device__ __forceinline__ void operator()(const f32x4 (&acc)[2][2][4][2], const pg8::Unit& u, int wr, int wc, int fr, int fq) const {
        const int row0 = u.pm * 256 + wr * 64 + fr, col0 = u.pn * 256 + wc * 32 + 4 * fq;
#pragma unroll
        for (int ai = 0; ai < 2; ++ai)
#pragma unroll
            for (int m = 0; m < 4; ++m) { const int row = row0 + ai * 128 + m * 16; float s = 0.f;
#pragma unroll
                for (int bj = 0; bj < 2; ++bj)
#pragma unroll
                    for (int n = 0; n < 2; ++n) { const f32x4 v = acc[ai][bj][m][n]; s += (v.x * v.x + v.y * v.y) + (v.z * v.z + v.w * v.w);
                        *(f32x4*)(Z + (size_t)row * DM + col0 + bj * 128 + n * 16) = v; }
                s += __shfl_xor(s, 16); s += __shfl_xor(s, 32);
                if (fq == 0) atomicAdd(ROWSQ + row, s); }
    }
};

__device__ __forceinline__ void phase_hgrn_naive(const Params& P, const Ctx& C) {
    float* qs = (float*)C.lds; float* fs = qs + 8192; float* ks = fs + 8192; float* vs = ks + 8192; float* part = vs + 1024; float* lbs = part + 8192;
    const int e = C.tid & 15, dg = C.tid >> 4;
    for (int unit = C.vcu; unit < 256; unit += C.G) {
        const int b = unit >> 5, h = (unit >> 3) & 3, es = unit & 7;
        __syncthreads();
        if (C.tid < 128) { const float l0 = P.in[I_LB][h * 128 + C.tid], l1 = P.in[I_LB][512 + h * 128 + C.tid]; lbs[C.tid] = 1.0f / (1.0f + __expf(l1 - l0)); }
        __syncthreads();
        float S0 = 0.f, S1 = 0.f, S2 = 0.f, S3 = 0.f;
        for (int c = 0; c < SEQ / 64; ++c) {
            const size_t row0 = (size_t)b * SEQ + c * 64;
#pragma unroll 4
            for (int j = 0; j < 16; ++j) { const int idx = C.tid + NTHR * j, t = idx >> 7, d = idx & 127;
                const bf16_t* p = C.PROJ + (row0 + t) * NIN + h * 128 + d;
                const float q = bf2f(p[C_HQ]), fz = bf2f(p[C_HF]), sg = sigmoidf_(fz), lb = lbs[d];
                qs[idx] = q; fs[idx] = lb + (1.f - lb) * sg; ks[idx] = (1.f - lb) * sigmoidf_(-fz); }
#pragma unroll
            for (int j = 0; j < 2; ++j) { const int idx = C.tid + NTHR * j, t = idx >> 4, ee = idx & 15;
                vs[idx] = bf2f(C.PROJ[(row0 + t) * NIN + C_HI + h * 128 + es * 16 + ee]); }
            __syncthreads();
            for (int t = 0; t < 64; ++t) {
                const f32x4 f4 = *(const f32x4*)(fs + t * 128 + dg * 4), k4 = *(const f32x4*)(ks + t * 128 + dg * 4), q4 = *(const f32x4*)(qs + t * 128 + dg * 4);
                const float v = vs[t * 16 + e];
                S0 = f4.x * S0 + k4.x * v; S1 = f4.y * S1 + k4.y * v; S2 = f4.z * S2 + k4.z * v; S3 = f4.w * S3 + k4.w * v;
                float po = (S0 * q4.x + S1 * q4.y) + (S2 * q4.z + S3 * q4.w);
                po += __shfl_xor(po, 16); po += __shfl_xor(po, 32);
                if (C.lane < 16) part[(t * 8 + C.wave) * 16 + C.lane] = po;
            }
            __syncthreads();
#pragma unroll
            for (int j = 0; j < 2; ++j) { const int idx = C.tid + NTHR * j, t = idx >> 4, ee = idx & 15; float s = 0.f;
#pragma unroll
                for (int w = 0; w < 8; ++w) s += part[(t * 8 + w) * 16 + ee];
                C.OARAW[(row0 + t) * 512 + h * 128 + es * 16 + ee] = s; }
            __syncthreads();
        }
    }
}


constexpr int HG_QH = 0, HG_KH = 17408, HG_KT = 34816, HG_VT = 53248, HG_PS = 71680, HG_ST = 80896, HG_SEG = 115712, HG_E31 = 117760, HG_E63 = 118272, HG_ROWP = 118784;
#define HG_BAR() do { asm volatile("s_waitcnt lgkmcnt(0)" ::: "memory"); __builtin_amdgcn_s_barrier(); asm volatile("" ::: "memory"); } while (0)
__device__ __forceinline__ void hgrn_chain(const Params& P, const Ctx& C, int b, int h) {
    unsigned char* L = C.lds;
    const int tid = C.tid, lane = C.lane, w = C.wave, fr = lane & 15, fq = lane >> 4, col = tid & 127, seg = tid >> 7;
    bf16_t* QH = (bf16_t*)(L + HG_QH); bf16_t* KH = (bf16_t*)(L + HG_KH); bf16_t* KT = (bf16_t*)(L + HG_KT); bf16_t* VT = (bf16_t*)(L + HG_VT);
    bf16_t* PS = (bf16_t*)(L + HG_PS); bf16_t* STw = (bf16_t*)(L + HG_ST + w * 4352);
    float* SEG = (float*)(L + HG_SEG); float* E31 = (float*)(L + HG_E31); float* E63 = (float*)(L + HG_E63); float* ROWP = (float*)(L + HG_ROWP);
    const float lb = 1.0f / (1.0f + __expf(P.in[I_LB][512 + h * 128 + col] - P.in[I_LB][h * 128 + col])), omlb = 1.0f - lb;
    const float gain = P.in[I_HGG][h * 128 + 16 * w + fr];
    const bf16_t* base = C.PROJ + (size_t)b * SEQ * NIN + h * 128;
    bf16_t* obase = C.OAB + (size_t)b * SEQ * DM + h * 128 + 16 * w + fr;
    f32x4 Sacc[8];
#pragma unroll
    for (int j = 0; j < 8; ++j) Sacc[j] = (f32x4){0.f, 0.f, 0.f, 0.f};
    unsigned short rq[16], rf[16], rv[16];
    { const bf16_t* p = base + (size_t)(16 * seg) * NIN + col;
#pragma unroll
      for (int i = 0; i < 16; ++i) { rq[i] = p[(size_t)i * NIN + C_HQ]; rf[i] = p[(size_t)i * NIN + C_HF]; rv[i] = p[(size_t)i * NIN + C_HI]; } }
    for (int c = 0; c < SEQ / 64; ++c) {
        const int row0 = c * 64;
        unsigned short rg[16];
#pragma unroll
        for (int mt = 0; mt < 4; ++mt)
#pragma unroll
            for (int i = 0; i < 4; ++i) rg[mt * 4 + i] = base[(size_t)(row0 + 16 * mt + 4 * fq + i) * NIN + C_HG + 16 * w + fr];
        float cs[16], kk[16], qq[16]; float run = 0.f;
#pragma unroll
        for (int i = 0; i < 16; ++i) { float fz = bf2f(rf[i]); fz = fminf(fmaxf(fz, -30.f), 30.f); const float e = __expf(-fz), sg = __builtin_amdgcn_rcpf(1.f + e);
            kk[i] = omlb * e * sg; run += __logf(lb + omlb * sg); cs[i] = run; qq[i] = bf2f(rq[i]); }
        SEG[seg * 128 + col] = run;
        { u32x4 v0, v1; v0.x = rv[0] | ((unsigned)rv[1] << 16); v0.y = rv[2] | ((unsigned)rv[3] << 16); v0.z = rv[4] | ((unsigned)rv[5] << 16); v0.w = rv[6] | ((unsigned)rv[7] << 16);
          v1.x = rv[8] | ((unsigned)rv[9] << 16); v1.y = rv[10] | ((unsigned)rv[11] << 16); v1.z = rv[12] | ((unsigned)rv[13] << 16); v1.w = rv[14] | ((unsigned)rv[15] << 16);
          *(u32x4*)(VT + col * 72 + seg * 16) = v0; *(u32x4*)(VT + col * 72 + seg * 16 + 8) = v1; }
        HG_BAR();
        { const float s0 = SEG[col], s1 = SEG[128 + col], s2 = SEG[256 + col], s3 = SEG[384 + col];
          const float prefix = (seg > 0 ? s0 : 0.f) + (seg > 1 ? s1 : 0.f) + (seg > 2 ? s2 : 0.f), b31 = s0 + s1, b63 = (s0 + s1) + (s2 + s3);
          unsigned kt[8];
#pragma unroll
          for (int i = 0; i < 16; i += 2) { const float bi0 = prefix + cs[i], bi1 = prefix + cs[i + 1];
              QH[(16 * seg + i) * 136 + col] = (bf16_t)f2bf(qq[i] * __expf(bi0 - b31)); QH[(16 * seg + i + 1) * 136 + col] = (bf16_t)f2bf(qq[i + 1] * __expf(bi1 - b31));
              KH[(16 * seg + i) * 136 + col] = (bf16_t)f2bf(kk[i] * __expf(b31 - bi0)); KH[(16 * seg + i + 1) * 136 + col] = (bf16_t)f2bf(kk[i + 1] * __expf(b31 - bi1));
              kt[i >> 1] = pk2(kk[i] * __expf(b63 - bi0), kk[i + 1] * __expf(b63 - bi1)); }
          *(u32x4*)(KT + col * 72 + seg * 16) = (u32x4){kt[0], kt[1], kt[2], kt[3]}; *(u32x4*)(KT + col * 72 + seg * 16 + 8) = (u32x4){kt[4], kt[5], kt[6], kt[7]};
          if (seg == 0) { E31[col] = __expf(b31); E63[col] = __expf(b63); } }
        if (c + 1 < SEQ / 64) { const bf16_t* p = base + (size_t)(row0 + 64 + 16 * seg) * NIN + col;
#pragma unroll
            for (int i = 0; i < 16; ++i) { rq[i] = p[(size_t)i * NIN + C_HQ]; rf[i] = p[(size_t)i * NIN + C_HF]; rv[i] = p[(size_t)i * NIN + C_HI]; } }
        HG_BAR();
#pragma unroll
        for (int j = 0; j < 8; ++j) { const float ev = E31[16 * j + fr];
#pragma unroll
            for (int i = 0; i < 4; ++i) STw[(4 * fq + i) * 136 + 16 * j + fr] = (bf16_t)f2bf(Sacc[j][i] * ev); }
#pragma unroll
        for (int q = 0; q < 2; ++q) { const int tt = 2 * w + q, ti = tt >> 2, sj = tt & 3; f32x4 pa = (f32x4){0.f, 0.f, 0.f, 0.f};
            if (sj <= ti) {
#pragma unroll
                for (int k4 = 0; k4 < 4; ++k4) { const bf16x8 a = *(const bf16x8*)(QH + (16 * ti + fr) * 136 + 32 * k4 + 8 * fq), bb = *(const bf16x8*)(KH + (16 * sj + fr) * 136 + 32 * k4 + 8 * fq);
                    pa = __builtin_amdgcn_mfma_f32_16x16x32_bf16(a, bb, pa, 0, 0, 0); }
                if (sj == ti) {
#pragma unroll
                    for (int i = 0; i < 4; ++i) if (fr > 4 * fq + i) pa[i] = 0.f; }
            }
#pragma unroll
            for (int i = 0; i < 4; ++i) PS[(16 * ti + 4 * fq + i) * 72 + 16 * sj + fr] = (bf16_t)f2bf(pa[i]); }
        f32x4 o[4];
#pragma unroll
        for (int mt = 0; mt < 4; ++mt) o[mt] = (f32x4){0.f, 0.f, 0.f, 0.f};
#pragma unroll
        for (int k4 = 0; k4 < 4; ++k4) { const bf16x8 bs = *(const bf16x8*)(STw + fr * 136 + 32 * k4 + 8 * fq);
#pragma unroll
            for (int mt = 0; mt < 4; ++mt) { const bf16x8 a = *(const bf16x8*)(QH + (16 * mt + fr) * 136 + 32 * k4 + 8 * fq); o[mt] = __builtin_amdgcn_mfma_f32_16x16x32_bf16(a, bs, o[mt], 0, 0, 0); } }
        HG_BAR();
        bf16x8 vf[2];
#pragma unroll
        for (int k2 = 0; k2 < 2; ++k2) vf[k2] = *(const bf16x8*)(VT + (16 * w + fr) * 72 + 32 * k2 + 8 * fq);
#pragma unroll
        for (int k2 = 0; k2 < 2; ++k2)
#pragma unroll
            for (int mt = 0; mt < 4; ++mt) { if (k2 == 1 && mt < 2) continue;
                const bf16x8 a = *(const bf16x8*)(PS + (16 * mt + fr) * 72 + 32 * k2 + 8 * fq); o[mt] = __builtin_amdgcn_mfma_f32_16x16x32_bf16(a, vf[k2], o[mt], 0, 0, 0); }
#pragma unroll
        for (int j = 0; j < 8; ++j) { const float ev = E63[16 * j + fr]; Sacc[j] = Sacc[j] * ev;
#pragma unroll
            for (int k2 = 0; k2 < 2; ++k2) { const bf16x8 bk = *(const bf16x8*)(KT + (16 * j + fr) * 72 + 32 * k2 + 8 * fq); Sacc[j] = __builtin_amdgcn_mfma_f32_16x16x32_bf16(vf[k2], bk, Sacc[j], 0, 0, 0); } }
#pragma unroll
        for (int mt = 0; mt < 4; ++mt)
#pragma unroll
            for (int i = 0; i < 4; ++i) { float ss = o[mt][i] * o[mt][i]; ss += __shfl_xor(ss, 1); ss += __shfl_xor(ss, 2); ss += __shfl_xor(ss, 4); ss += __shfl_xor(ss, 8);
                if (fr == 0) ROWP[(16 * mt + 4 * fq + i) * 8 + w] = ss; }
        HG_BAR();
#pragma unroll
        for (int mt = 0; mt < 4; ++mt)
#pragma unroll
            for (int i = 0; i < 4; ++i) { const int t = 16 * mt + 4 * fq + i; const f32x4 p0 = *(const f32x4*)(ROWP + t * 8), p1 = *(const f32x4*)(ROWP + t * 8 + 4);
                const float r = rsqrtf(((p0.x + p0.y) + (p0.z + p0.w) + (p1.x + p1.y) + (p1.z + p1.w)) * (1.f / 128.f) + RMS_EPS);
                const float g = bf2f(rg[mt * 4 + i]);
                obase[(size_t)(row0 + t) * DM] = (bf16_t)f2bf(o[mt][i] * r * gain * (g * sigmoidf_(g))); }
    }
    HG_BAR();
}

__device__ __forceinline__ void phase_attn(const Ctx& C, unsigned* ctr) {
    volatile unsigned* word = (volatile unsigned*)(C.lds + LDS_BYTES - 64);
    for (;;) {
        if (C.tid == 0) *word = atomicAdd(ctr, 1u);
        __syncthreads();
        const unsigned id = *word;
        if (id >= 4096u) break;
        const int qb = 31 - (int)(id >> 7), vhd = (int)(id & 127u);
        const int b = vhd >> 4, h = (vhd >> 2) & 3, j = (vhd >> 1) & 1, vh = vhd & 1;
        const attn_body::bf16* Q = (const attn_body::bf16*)(C.PROJ + C_DQ + (h * 2 + j) * 64);
        const attn_body::bf16* K = (const attn_body::bf16*)(C.PROJ + C_DK + (h * 2 + j) * 64);
        const attn_body::bf16* V = (const attn_body::bf16*)(C.PROJ + C_DV + h * 128 + vh * 64);
        attn_body::bf16* O = (attn_body::bf16*)(C.OB4 + (h * 2 + j) * 128 + vh * 64);
        attn_body::attn_unit<8>(b, 0, qb, Q, K, V, O, (char*)C.lds);
    }
}

__device__ __forceinline__ void phase_branch_norm(const Params& P, const Ctx& C) {
    const int gw = C.vcu * 8 + C.wave, NGW = C.G * 8, l2 = C.lane * 2;
    float s1 = P.in[I_LQ1][C.lane] * P.in[I_LK1][C.lane], s2 = P.in[I_LQ2][C.lane] * P.in[I_LK2][C.lane];
    s1 = wave_sum(s1); s2 = wave_sum(s2);
    const float lam = __expf(s1) - __expf(s2) + LAM_INIT;
    for (int m = gw; m < NTOK; m += NGW) {
        const bf16_t* pr = C.PROJ + (size_t)m * NIN; bf16_t* oab = C.OAB + (size_t)m * DM;
#pragma unroll
        for (int h = 0; h < 4; ++h) {
            {
                const unsigned u1 = *(const unsigned*)(C.OB4 + (size_t)m * DM + (h * 2 + 0) * 128 + l2), u2 = *(const unsigned*)(C.OB4 + (size_t)m * DM + (h * 2 + 1) * 128 + l2);
                const float o0 = bf2f(u1 & 0xffffu) - lam * bf2f(u2 & 0xffffu), o1 = bf2f(u1 >> 16) - lam * bf2f(u2 >> 16);
                const float r = rsqrtf(wave_sum(o0 * o0 + o1 * o1) * (1.f / 128.f) + RMS_EPS) * (1.0f - LAM_INIT);
                const unsigned g = *(const unsigned*)(pr + C_DG + h * 128 + l2); const float g0 = bf2f(g & 0xffffu), g1 = bf2f(g >> 16);
                const f32x2 gn = *(const f32x2*)(P.in[I_DNG] + h * 128 + l2);
                *(unsigned*)(oab + 512 + h * 128 + l2) = pk2(o0 * r * gn.x * (g0 * sigmoidf_(g0)), o1 * r * gn.y * (g1 * sigmoidf_(g1)));
            }
        }
    }
}

__device__ __forceinline__ void phase_final(const Params& P, const Ctx& C) {
    const int gw = C.vcu * 8 + C.wave, NGW = C.G * 8;
    const float* gpo = P.in[I_GPOST];
    for (int m = gw; m < NTOK; m += NGW) {
        const int b = m >> 13;
        const float rstd = rsqrtf(C.ROWSQ[m] * (1.f / DM) + RMS_EPS);
        const f32x4* xr = (const f32x4*)(P.in[I_X] + (size_t)m * DM) + C.lane; f32x4* zr = (f32x4*)(P.out + (size_t)m * DM) + C.lane;
#pragma unroll
        for (int j = 0; j < 4; ++j) { const int idx = (C.lane + 64 * j) * 4;
            const f32x4 g = *(const f32x4*)(gpo + idx), gt = *(const f32x4*)(C.MOD + b * 3072 + 2048 + idx);
            zr[64 * j] = xr[64 * j] + gt * (zr[64 * j] * rstd * g); }
    }
}

__global__ void __launch_bounds__(NTHR, 2) fwd_kernel(Params P) {
    extern __shared__ __attribute__((aligned(16))) unsigned char lds[];
    cg::grid_group grid = cg::this_grid();
    Ctx C;
    C.lds = lds; C.tid = threadIdx.x; C.lane = C.tid & 63; C.wave = __builtin_amdgcn_readfirstlane(C.tid >> 6);
    C.G = gridDim.x; { const int bx = blockIdx.x; C.vcu = (C.G % 8 == 0) ? (bx % 8) * (C.G / 8) + bx / 8 : bx; }
    unsigned char* ws = P.ws;
    C.ROWSQ = (float*)(ws + WS_ROWSQ); C.MOD = (float*)(ws + WS_MOD);
    C.WIN = (bf16_t*)(ws + WS_WIN); C.WAB = (bf16_t*)(ws + WS_WAB); C.WOUT = (bf16_t*)(ws + WS_WOUT);
    C.XN = (bf16_t*)(ws + WS_XN); C.OAB = C.XN; C.PROJ = (bf16_t*)(ws + WS_PROJ);
    C.OARAW = P.out; C.OB4 = (bf16_t*)((unsigned char*)P.out + 128 * MiB);

#define FRESH() do { int t_ = threadIdx.x; asm volatile("" : "+v"(t_)); C.tid = t_; C.lane = t_ & 63; C.wave = __builtin_amdgcn_readfirstlane(t_ >> 6); } while (0)
    phase_prologue(P, C);
    grid.sync(); FRESH();
    phase_prenorm(P, C);
    grid.sync(); FRESH();
    { pg8::Gemm g{C.XN, C.WIN, NTOK, NIN, DM, DM, DM}; pg8::StaticOrder S; S.init(NTOK, NIN, C.G, (int)blockIdx.x); EpiProj2 E{C.PROJ};
      pg8::gemm_phase<EpiProj2, pg8::StaticOrder, true, true>((PG8_LAS unsigned char*)lds, g, S, E); }
    grid.sync(); FRESH();
    for (int ch = blockIdx.x; ch < 32; ch += C.G) { hgrn_chain(P, C, ch >> 2, ch & 3); FRESH(); }
    phase_attn(C, (unsigned*)(ws + WS_QCTR));
    grid.sync(); FRESH();
    phase_branch_norm(P, C);
    grid.sync(); FRESH();
    { pg8::Gemm g{C.OAB, C.WAB, NTOK, DM, DM, DM, DM}; pg8::StaticOrder S; S.init(NTOK, DM, C.G, (int)blockIdx.x); EpiMerge2 E{C.PROJ, C.PROJ};
      pg8::gemm_phase<EpiMerge2, pg8::StaticOrder, true, true>((PG8_LAS unsigned char*)lds, g, S, E); }
    grid.sync(); FRESH();
    { pg8::Gemm g{C.PROJ, C.WOUT, NTOK, DM, DM, NIN, DM}; pg8::StaticOrder S; S.init(NTOK, DM, C.G, (int)blockIdx.x); EpiZ2 E{P.out, C.ROWSQ};
      pg8::gemm_phase<EpiZ2, pg8::StaticOrder, true, true>((PG8_LAS unsigned char*)lds, g, S, E); }
    grid.sync(); FRESH();
    phase_final(P, C);
}

extern "C" void kernel_launch(void* const* d_in, const int* in_sizes, int n_in, void* d_out, int out_size, void* d_ws, size_t ws_size, hipStream_t stream) {
    static int grid = 0;
    if (grid == 0) {
        if (n_in != 17 || out_size != NTOK * DM || ws_size < WS_END) { fprintf(stderr, "kernel_launch: unexpected shapes (n_in %d out %d ws %zu)\n", n_in, out_size, ws_size); grid = -1; return; }
        int dev = 0, cus = 0, per_cu = 0;
        hipGetDevice(&dev); hipDeviceGetAttribute(&cus, hipDeviceAttributeMultiprocessorCount, dev);
        hipFuncSetAttribute((const void*)fwd_kernel, hipFuncAttributeMaxDynamicSharedMemorySize, LDS_BYTES);
        hipOccupancyMaxActiveBlocksPerMultiprocessor(&per_cu, (const void*)fwd_kernel, NTHR, LDS_BYTES);
        if (per_cu < 1) { fprintf(stderr, "kernel_launch: occupancy query says %d blocks per CU\n", per_cu); per_cu = 1; }
        grid = cus * 1;
        (void)hipGetLastError();
    }
    if (grid < 0) return;
    Params p{};
    for (int i = 0; i < 17; ++i) p.in[i] = (const float*)d_in[i];
    p.out = (float*)d_out; p.ws = (unsigned char*)d_ws;
    void* args[] = {&p};
    hipError_t e = hipLaunchCooperativeKernel((const void*)fwd_kernel, dim3(grid), dim3(NTHR), args, LDS_BYTES, stream);
    if (e != hipSuccess) fprintf(stderr, "cooperative launch failed: %s (grid %d)\n", hipGetErrorString(e), grid);
}
```

```cpp
#include <hip/hip_runtime.h>
#include <hip/hip_cooperative_groups.h>
#include <cstdio>
#include <cstdint>
namespace cg = cooperative_groups;
namespace pg8 {
#define PG8_LAS __attribute__((address_space(3)))
typedef unsigned short bf16_t;
typedef short bf16x8 __attribute__((ext_vector_type(8)));
typedef float f32x4 __attribute__((ext_vector_type(4)));
typedef unsigned u32x4 __attribute__((ext_vector_type(4)));
constexpr int BM = 256, BK = 64, HALF = 128, HTB = HALF * BK * 2  , STAGE_BYTES = 8 * HTB, NXCD = 8, WGM = 8;

__host__ __device__ __forceinline__ int lds_byte(int r, int c) { const int st = (r >> 4) * 2 + (c >> 5), rr = r & 15, cc = c & 31, ob = rr * 64 + cc * 2; return st * 1024 + (ob ^ (((ob >> 9) & 1) << 5)); }
__host__ __device__ __forceinline__ void stage_rc(int b, int& R, int& C) { const int st = b / 1024, sb = b % 1024, swz = sb ^ (((sb >> 9) & 1) << 5); R = (st >> 1) * 16 + swz / 64; C = (st & 1) * 32 + (swz % 64) / 2; }
__host__ __device__ __forceinline__ int perm32(int rho) { const int n = rho >> 4, i = rho & 15; return 8 * (i >> 2) + 4 * n + (i & 3); }

struct Unit { int pm, pn; };
struct Gemm { const bf16_t* A; const bf16_t* Bt; int M, N, K, lda, ldb; };

struct StaticOrder {
    int nM, nN, nwg, G, c;
    __host__ __device__ void init(int M, int N, int G_, int c_) { nM = M / BM; nN = N / BM; nwg = nM * nN; G = G_; c = c_; }
    __host__ __device__ bool next(int i, Unit& u) const {
        const long L = (long)i * G + c; if (L >= nwg) return false;
        int wgid = (int)L; { const int q = nwg / NXCD, r = nwg % NXCD, xcd = wgid % NXCD, off = wgid / NXCD; wgid = (xcd < r ? xcd * (q + 1) : r * (q + 1) + (xcd - r) * q) + off; }
        const int nig = WGM * nN, gid = wgid / nig, fm = gid * WGM, gsz = (nM - fm) < WGM ? (nM - fm) : WGM;
        u.pm = fm + ((wgid % nig) % gsz); u.pn = (wgid % nig) / gsz; return true;
    }
    __device__ __forceinline__ void a_ready(const Unit&) const {}
    __device__ __forceinline__ void done(const Unit&) const {}
};

__device__ __forceinline__ unsigned cvt_pk_bf16(float lo, float hi) { unsigned r; asm volatile("v_cvt_pk_bf16_f32 %0, %1, %2" : "=v"(r) : "v"(lo), "v"(hi)); return r; }
typedef float f32x2 __attribute__((ext_vector_type(2)));
template <class Epi, class Sched, bool ALIGN_EPI = false, bool SP2 = false>
__device__ __forceinline__ void gemm_phase(PG8_LAS unsigned char* lds, const Gemm g, const Sched& S, const Epi& E, int tid_in) {
    int tid_ = tid_in; asm volatile("" : "+v"(tid_));
    const int tid = tid_, wid = __builtin_amdgcn_readfirstlane(tid >> 6), lane = tid & 63, wr = wid >> 2, wc = wid & 3, fr = lane & 15, fq = lane >> 4;
    const int K = g.K, nt = K / BK;
    unsigned voffA[2], voffB[2];
#pragma unroll
    for (int i = 0; i < 2; ++i) { int R, C; stage_rc(tid * 16 + i * 8192, R, C); const int Rb = Epi::PERM ? ((R & ~31) + perm32(R & 31)) : R;
        voffA[i] = (unsigned)(R * g.lda + C) * 2u; voffB[i] = (unsigned)(Rb * g.ldb + C) * 2u; }
    const size_t kstep = (size_t)(BK * 2);
    const size_t hstepA = (size_t)HALF * g.lda * 2, hstepB = (size_t)HALF * g.ldb * 2;
    const size_t tstepA = 2 * hstepA, tstepB = 2 * hstepB;
    const unsigned ldsw = (unsigned)wid * 1024u;
    const int aoff = lds_byte(wr * 64 + fr, fq * 8), boff = lds_byte(wc * 32 + fr, fq * 8);
#define PG8_SA(b, h) (((b) * 2 + (h)) * HTB)
#define PG8_SB(b, h) ((4 + (b) * 2 + (h)) * HTB)
#define PG8_STAGE(bufoff, gbase, voff) do { _Pragma("unroll") for (int _i = 0; _i < 2; ++_i) \
        __builtin_amdgcn_global_load_lds((const unsigned*)((const char*)(gbase) + (voff)[_i]), (PG8_LAS unsigned*)(lds + (bufoff) + ldsw + _i * 8192), 16, 0, 0); } while (0)
#define PG8_LDA(dst, b, h) do { _Pragma("unroll") for (int m = 0; m < 4; ++m) _Pragma("unroll") for (int k = 0; k < 2; ++k) dst[m][k] = *(const PG8_LAS bf16x8*)(lds + PG8_SA(b, h) + aoff + m * 2048 + k * 1024); } while (0)
#define PG8_LDB(dst, b, h) do { _Pragma("unroll") for (int n = 0; n < 2; ++n) _Pragma("unroll") for (int k = 0; k < 2; ++k) dst[n][k] = *(const PG8_LAS bf16x8*)(lds + PG8_SB(b, h) + boff + n * 2048 + k * 1024); } while (0)
#define PG8_MMA(ai, bj, At, Bt) do { __builtin_amdgcn_s_setprio(1); _Pragma("unroll") for (int m = 0; m < 4; ++m) _Pragma("unroll") for (int n = 0; n < 2; ++n) _Pragma("unroll") for (int k = 0; k < 2; ++k) \
        acc[ai][bj][m][n] = __builtin_amdgcn_mfma_f32_16x16x32_bf16(Bt[n][k], At[m][k], acc[ai][bj][m][n], 0, 0, 0); __builtin_amdgcn_s_setprio(0); } while (0)
#define PG8_WAIT_V(n) asm volatile("s_waitcnt vmcnt(" #n ")" ::: "memory")
#define PG8_WAIT_L(n) asm volatile("s_waitcnt lgkmcnt(" #n ")" ::: "memory")
#define PG8_BAR __builtin_amdgcn_s_barrier()
#define PG8_SCHED __builtin_amdgcn_sched_barrier(0)
    Unit cur, nxt; int ui = 0;
    if (!S.next(0, cur)) return;
    f32x4 acc[2][2][4][2];
#pragma unroll
    for (int a = 0; a < 2; ++a)
#pragma unroll
        for (int b = 0; b < 2; ++b)
#pragma unroll
            for (int m = 0; m < 4; ++m)
#pragma unroll
                for (int n = 0; n < 2; ++n) acc[a][b][m][n] = (f32x4){0.f, 0.f, 0.f, 0.f};
    bf16x8 At[4][2], B0[2][2], B1[2][2];
    const char* cA = (const char*)g.A + (size_t)cur.pm * tstepA; const char* cB = (const char*)g.Bt + (size_t)cur.pn * tstepB;
    S.a_ready(cur);
    if constexpr (SP2) {
        PG8_STAGE(PG8_SB(0, 0), cB, voffB); PG8_STAGE(PG8_SB(0, 1), cB + hstepB, voffB); PG8_STAGE(PG8_SA(0, 0), cA, voffA); PG8_STAGE(PG8_SA(0, 1), cA + hstepA, voffA);
        if (wr == 1) PG8_BAR;
        PG8_WAIT_V(2); PG8_BAR;
        PG8_STAGE(PG8_SB(1, 0), cB + kstep, voffB); PG8_STAGE(PG8_SA(1, 0), cA + kstep, voffA); PG8_STAGE(PG8_SB(1, 1), cB + hstepB + kstep, voffB);
        PG8_WAIT_V(6); PG8_BAR;
    } else {
        PG8_STAGE(PG8_SB(0, 0), cB, voffB); PG8_STAGE(PG8_SA(0, 0), cA, voffA); PG8_STAGE(PG8_SB(0, 1), cB + hstepB, voffB); PG8_STAGE(PG8_SA(0, 1), cA + hstepA, voffA);
        if (wr == 1) PG8_BAR;
        PG8_WAIT_V(4); PG8_BAR;
        PG8_STAGE(PG8_SB(1, 0), cB + kstep, voffB); PG8_STAGE(PG8_SA(1, 0), cA + kstep, voffA); PG8_STAGE(PG8_SB(1, 1), cB + hstepB + kstep, voffB);
        PG8_WAIT_V(6); PG8_BAR;
    }
    for (;;) {
        const bool has_next = S.next(ui + 1, nxt);
        const char* nA = has_next ? (const char*)g.A + (size_t)nxt.pm * tstepA : cA; const char* nB = has_next ? (const char*)g.Bt + (size_t)nxt.pn * tstepB : cB;
        for (int t = 0; t < nt; t += 2) {
            const bool last = (t == nt - 2);
            const char* a1 = cA + (size_t)(t + 1) * kstep;
            const char* a2 = last ? nA : cA + (size_t)(t + 2) * kstep; const char* b2 = last ? nB : cB + (size_t)(t + 2) * kstep;
            const char* a3 = a2 + kstep; const char* b3 = b2 + kstep;
            if (last && has_next) S.a_ready(nxt);
            if constexpr (Epi::MID) { if (t == nt / 2) E.mid(acc, cur, wr, wc, fr, fq); }
            if constexpr (SP2) {
            PG8_LDB(B0, 0, 0); PG8_LDB(B1, 0, 1); PG8_SCHED; PG8_LDA(At, 0, 0); PG8_STAGE(PG8_SA(1, 1), a1 + hstepA, voffA);
            PG8_WAIT_V(8); PG8_WAIT_L(0); PG8_BAR; PG8_MMA(0, 0, At, B0); PG8_MMA(0, 1, At, B1); PG8_BAR; PG8_SCHED;
            PG8_LDA(At, 0, 1); PG8_STAGE(PG8_SB(0, 0), b2, voffB); PG8_STAGE(PG8_SB(0, 1), b2 + hstepB, voffB); PG8_STAGE(PG8_SA(0, 0), a2, voffA);
            PG8_WAIT_V(8); PG8_WAIT_L(0); PG8_BAR; PG8_MMA(1, 0, At, B0); PG8_MMA(1, 1, At, B1); PG8_BAR; PG8_SCHED;
            PG8_LDB(B0, 1, 0); PG8_LDB(B1, 1, 1); PG8_SCHED; PG8_LDA(At, 1, 0); PG8_STAGE(PG8_SA(0, 1), a2 + hstepA, voffA);
            PG8_WAIT_V(8); PG8_WAIT_L(0); PG8_BAR; PG8_MMA(0, 0, At, B0); PG8_MMA(0, 1, At, B1); PG8_BAR; PG8_SCHED;
            PG8_LDA(At, 1, 1); PG8_STAGE(PG8_SB(1, 0), b3, voffB); PG8_STAGE(PG8_SB(1, 1), b3 + hstepB, voffB); PG8_STAGE(PG8_SA(1, 0), a3, voffA);
            PG8_WAIT_V(8); PG8_WAIT_L(0); PG8_BAR; PG8_MMA(1, 0, At, B0); PG8_MMA(1, 1, At, B1); PG8_BAR; PG8_SCHED;
            } else {
            PG8_LDB(B0, 0, 0); PG8_SCHED; PG8_LDA(At, 0, 0); PG8_STAGE(PG8_SA(1, 1), a1 + hstepA, voffA);
            PG8_WAIT_L(8); PG8_BAR; PG8_WAIT_L(0); PG8_MMA(0, 0, At, B0); PG8_BAR; PG8_SCHED;
            PG8_LDB(B1, 0, 1); PG8_STAGE(PG8_SB(0, 0), b2, voffB);
            PG8_BAR; PG8_WAIT_L(0); PG8_MMA(0, 1, At, B1); PG8_BAR;
            PG8_LDA(At, 0, 1); PG8_STAGE(PG8_SA(0, 0), a2, voffA);
            PG8_BAR; PG8_WAIT_L(0); PG8_MMA(1, 0, At, B0); PG8_BAR; PG8_SCHED;
            PG8_STAGE(PG8_SB(0, 1), b2 + hstepB, voffB);
            PG8_WAIT_V(6); PG8_BAR; PG8_MMA(1, 1, At, B1); PG8_BAR;
            PG8_LDB(B0, 1, 0); PG8_SCHED; PG8_LDA(At, 1, 0); PG8_STAGE(PG8_SA(0, 1), a2 + hstepA, voffA);
            PG8_WAIT_L(8); PG8_BAR; PG8_WAIT_L(0); PG8_MMA(0, 0, At, B0); PG8_BAR; PG8_SCHED;
            PG8_LDB(B1, 1, 1); PG8_STAGE(PG8_SB(1, 0), b3, voffB);
            PG8_BAR; PG8_WAIT_L(0); PG8_MMA(0, 1, At, B1); PG8_BAR;
            PG8_LDA(At, 1, 1); PG8_STAGE(PG8_SA(1, 0), a3, voffA);
            PG8_BAR; PG8_WAIT_L(0); PG8_MMA(1, 0, At, B0); PG8_BAR; PG8_SCHED;
            PG8_STAGE(PG8_SB(1, 1), b3 + hstepB, voffB);
            PG8_WAIT_V(6); PG8_BAR; PG8_MMA(1, 1, At, B1); PG8_BAR;
            }
        }
        if constexpr (ALIGN_EPI) { if (wr == 0) PG8_BAR; }
        if constexpr (!Epi::AFTER_DRAIN) { E(acc, cur, wr, wc, fr, fq); S.done(cur); }
        if constexpr (Epi::POST) { static_assert(ALIGN_EPI, "post hook: both half-workgroups must be barrier-aligned here"); E.post(cur, lds, tid); }
        if (!has_next) break;
#pragma unroll
        for (int a = 0; a < 2; ++a)
#pragma unroll
            for (int b = 0; b < 2; ++b)
#pragma unroll
                for (int m = 0; m < 4; ++m)
#pragma unroll
                    for (int n = 0; n < 2; ++n) acc[a][b][m][n] = (f32x4){0.f, 0.f, 0.f, 0.f};
        cur = nxt; cA = nA; cB = nB; ++ui;
        if constexpr (ALIGN_EPI) { if (wr == 1) PG8_BAR; }
    }
    PG8_WAIT_V(0);
    if constexpr (!ALIGN_EPI) { if (wr == 0) PG8_BAR; }
    PG8_BAR;
    if constexpr (Epi::AFTER_DRAIN) { E.fused(acc, cur, wr, wc, fr, fq, lds, wid, lane); S.done(cur); }
#undef PG8_SA
#undef PG8_SB
#undef PG8_STAGE
#undef PG8_LDA
#undef PG8_LDB
#undef PG8_MMA
#undef PG8_WAIT_V
#undef PG8_WAIT_L
#undef PG8_BAR
#undef PG8_SCHED
}
}
#include <hip/hip_bf16.h>
#include <cmath>
namespace attn_body {
using bf16=__hip_bfloat16;
using bf16x8=__attribute__((ext_vector_type(8)))short;
using s16x4=__attribute__((ext_vector_type(4)))short;
using f32x16=__attribute__((ext_vector_type(16)))float;
using u32x4=__attribute__((ext_vector_type(4)))unsigned;
constexpr int SEQ=8192,D=64,PIN=6272,PO=1024,PK=64,PV=128;
constexpr int NW=8,QBLK=32,QB=QBLK*NW,KVBLK=64,NQB=SEQ/QB;
constexpr int ATTN_UNIT_ROWS=QB;
__device__ __forceinline__ int crow(int r,int hi){return (r&3)+8*(r>>2)+4*hi;}
#define SBAR() __builtin_amdgcn_sched_barrier(0)
__device__ __forceinline__ void cmask(f32x16&p0,f32x16&p1,int jb,int qrel,int hi){
  const float NEG=-INFINITY; int kb=64*jb+4*hi;
  #pragma unroll
  for(int r=0;r<16;++r){int kv=kb+(r&3)+8*(r>>2); if(kv>qrel)p0[r]=NEG; if(kv+32>qrel)p1[r]=NEG;}
}

constexpr int NSLOT=3, SLOTB=8192;
constexpr int LDS_K=0, LDS_V=NSLOT*SLOTB, LDS_WS=2*NSLOT*SLOTB, LDS_OST=LDS_WS+NW*64*4, LDS_BYTES=LDS_OST+NW*4096;
constexpr float C2=0.125f*1.4426950408889634f;
__device__ __forceinline__ void glds16(const void*gsrc,unsigned lds_dst){unsigned keep;
  asm volatile("s_mov_b32 %0, m0\n\ts_mov_b32 m0, %2\n\ts_nop 0\n\tglobal_load_lds_dwordx4 %1, off\n\ts_mov_b32 m0, %0":"=&s"(keep):"v"(gsrc),"s"(lds_dst):"memory");}
__device__ __forceinline__ float max3f(float a,float b,float c){float r;asm("v_max3_f32 %0, %1, %2, %3":"=v"(r):"v"(a),"v"(b),"v"(c));return r;}
__device__ __forceinline__ float max2f(float a,float b){float r;asm("v_max_f32_e32 %0, %1, %2":"=v"(r):"v"(a),"v"(b));return r;}
__device__ __forceinline__ float fadd_s(float a,float b){float r;asm("v_add_f32_e32 %0, %1, %2":"=v"(r):"v"(a),"v"(b));return r;}
__device__ __forceinline__ float fsub_s(float a,float b){float r;asm("v_sub_f32_e32 %0, %1, %2":"=v"(r):"v"(a),"v"(b));return r;}
typedef float f32x2_t __attribute__((ext_vector_type(2))); typedef __bf16 bf16x2_t __attribute__((ext_vector_type(2)));
__device__ __forceinline__ unsigned cvtpk_s(float lo,float hi){f32x2_t v={lo,hi};bf16x2_t b=__builtin_convertvector(v,bf16x2_t);return __builtin_bit_cast(unsigned,b);}
#define WAIT_BAR(N) asm volatile("s_waitcnt vmcnt(" #N ") lgkmcnt(0)\n\ts_barrier":::"memory")

__device__ __forceinline__ void qkt(f32x16&p0,f32x16&p1,const char*Kslot,const bf16x8*qr,const f32x16&negm,int r32,int hi){
  const char*kb=Kslot+hi*1024+r32*16;
  #pragma unroll
  for(int d0=0;d0<4;++d0){
    const bf16x8 b0=*reinterpret_cast<const bf16x8*>(kb+d0*2048);
    const bf16x8 b1=*reinterpret_cast<const bf16x8*>(kb+d0*2048+512);
    if(d0==0){p0=__builtin_amdgcn_mfma_f32_32x32x16_bf16(b0,qr[0],negm,0,0,0);p1=__builtin_amdgcn_mfma_f32_32x32x16_bf16(b1,qr[0],negm,0,0,0);}
    else{p0=__builtin_amdgcn_mfma_f32_32x32x16_bf16(b0,qr[d0],p0,0,0,0);p1=__builtin_amdgcn_mfma_f32_32x32x16_bf16(b1,qr[d0],p1,0,0,0);}}
}
typedef __attribute__((address_space(3))) const char* lds_cptr;
typedef short v4i16_t __attribute__((ext_vector_type(4)));
__device__ __forceinline__ void kload8(bf16x8*kf,lds_cptr kp){
  kf[0]=*(const __attribute__((address_space(3))) bf16x8*)(kp);      kf[1]=*(const __attribute__((address_space(3))) bf16x8*)(kp+512);
  kf[2]=*(const __attribute__((address_space(3))) bf16x8*)(kp+2048); kf[3]=*(const __attribute__((address_space(3))) bf16x8*)(kp+2560);
  kf[4]=*(const __attribute__((address_space(3))) bf16x8*)(kp+4096); kf[5]=*(const __attribute__((address_space(3))) bf16x8*)(kp+4608);
  kf[6]=*(const __attribute__((address_space(3))) bf16x8*)(kp+6144); kf[7]=*(const __attribute__((address_space(3))) bf16x8*)(kp+6656);
}
__device__ __forceinline__ void kload2(bf16x8*kf,lds_cptr kp,int j){ kf[2*j]=*(const __attribute__((address_space(3))) bf16x8*)(kp+j*2048); kf[2*j+1]=*(const __attribute__((address_space(3))) bf16x8*)(kp+j*2048+512); }
__device__ __forceinline__ s16x4 vtr(lds_cptr p){ return __builtin_bit_cast(s16x4,__builtin_amdgcn_ds_read_tr16_b64_v4i16((__attribute__((address_space(3))) v4i16_t*)p)); }
__device__ __forceinline__ float rowmax(const f32x16&p0,const f32x16&p1){
  float a=max3f(p0[0],p0[1],p1[0]),b=max3f(p0[2],p0[3],p1[1]);a=max3f(a,p1[2],p1[3]);
  #pragma unroll
  for(int r=4;r<16;r+=4){a=max3f(a,p0[r],p0[r+1]);b=max3f(b,p0[r+2],p0[r+3]);a=max3f(a,p1[r],p1[r+1]);b=max3f(b,p1[r+2],p1[r+3]);}
  const float m=max2f(a,b);
  auto rr=__builtin_amdgcn_permlane32_swap(__float_as_uint(m),__float_as_uint(m),false,false);
  return max2f(__uint_as_float(rr[0]),__uint_as_float(rr[1]));
}
__device__ __forceinline__ void pv(f32x16*o,int vb,bf16x8 pa0,bf16x8 pa1,bf16x8 pa2,bf16x8 pa3){
  #pragma unroll
  for(int d0=0;d0<2;++d0){s16x4 lo[4],hi[4];
    #pragma unroll
    for(int ks=0;ks<4;++ks){
      asm volatile("ds_read_b64_tr_b16 %0,%1 offset:%c2":"=&v"(lo[ks]):"v"(vb),"i"(d0*4096+ks*1024):"memory");
      asm volatile("ds_read_b64_tr_b16 %0,%1 offset:%c2":"=&v"(hi[ks]):"v"(vb),"i"(d0*4096+ks*1024+512):"memory");}
    asm volatile("s_waitcnt lgkmcnt(0)":::"memory");SBAR();
    #define PK(k) (bf16x8){lo[k][0],lo[k][1],lo[k][2],lo[k][3],hi[k][0],hi[k][1],hi[k][2],hi[k][3]}
    o[d0]=__builtin_amdgcn_mfma_f32_32x32x16_bf16(pa0,PK(0),o[d0],0,0,0);
    o[d0]=__builtin_amdgcn_mfma_f32_32x32x16_bf16(pa1,PK(1),o[d0],0,0,0);
    o[d0]=__builtin_amdgcn_mfma_f32_32x32x16_bf16(pa2,PK(2),o[d0],0,0,0);
    o[d0]=__builtin_amdgcn_mfma_f32_32x32x16_bf16(pa3,PK(3),o[d0],0,0,0);
    #undef PK
  }
}

#ifndef ATTN_STORE16
#define ATTN_STORE16(p,v) (*(u32x4*)(p)=(v))
#endif
template<int THRL> __device__ __forceinline__ void attn_unit(int b,int h,int qb,const bf16*Q,const bf16*__restrict__ K,const bf16*__restrict__ V,bf16*O,char*shm){
  const int tid=h,lane=tid&63,r32=lane&31,hi=lane>>5;     const int wid=__builtin_amdgcn_readfirstlane(tid>>6);
  const long rowbase=(long)b*SEQ; const int q0=qb*QB;
  const bf16*Qw=Q+(rowbase+q0+wid*QBLK)*PIN;
  const bf16*Kh=K,*Vh=V;
  const unsigned lds0=(unsigned)(uintptr_t)shm;
  float*wsf=(float*)(shm+LDS_WS)+wid*64;
  const bf16*ksrc=Kh+(long)lane*PK+wid*8;
  const bf16*vsrc=Vh+(long)(16*(wid&3)+(lane>>2))*PV+(wid>>2)*32+(lane&3)*8;
  const unsigned kdst=lds0+LDS_K+wid*1024, vdst=lds0+LDS_V+wid*1024;
  #define DMA_K(t,slot) glds16(ksrc+(long)(t)*KVBLK*PK,(unsigned)__builtin_amdgcn_readfirstlane(kdst+(slot)))
  #define DMA_V(t,slot) glds16(vsrc+(long)(t)*KVBLK*PV,(unsigned)__builtin_amdgcn_readfirstlane(vdst+(slot)))
  const int vb0=(int)(lds0+LDS_V)+((lane>>4)&1)*32+(lane&3)*8+(4*hi+((lane&15)>>2))*64;
  const char*Kbase=shm+LDS_K; bf16x8 kf[8];
  const lds_cptr shm3=(lds_cptr)shm; const lds_cptr kp0=shm3+LDS_K+hi*1024+r32*16; const lds_cptr vp0=shm3+LDS_V+((lane>>4)&1)*32+(lane&3)*8+(4*hi+((lane&15)>>2))*64;
  const int NT=(q0+QB)/KVBLK;
  DMA_K(0,0);DMA_V(0,0);DMA_K(1,SLOTB);
  bf16x8 qr[4];
  #pragma unroll
  for(int d0=0;d0<4;++d0)qr[d0]=*reinterpret_cast<const bf16x8*>(&Qw[(long)r32*PIN+d0*16+hi*8]);
  float mhat=0.f,l_reg=0.f;float zz_;asm volatile("v_mov_b32 %0, 0":"=v"(zz_));f32x16 o[2];_Pragma("unroll") for(int r=0;r<16;++r){o[0][r]=zz_;o[1][r]=zz_;}f32x16 negm;_Pragma("unroll") for(int r=0;r<16;++r)negm[r]=zz_;asm volatile("":"+v"(negm));
  const int qrel=wid*QBLK+r32;
  #define CMASK(P0,P1,t) do{int jb_=(t)-(NT-4); if(jb_>=0)cmask(P0,P1,jb_,qrel,hi);}while(0)
  bool resc=false;
  #define START(P0,P1) do{ const float rm=rowmax(P0,P1); resc=false; \
    { const float dl=rm; mhat=fadd_s(mhat,dl); \
      _Pragma("unroll") for(int r=0;r<16;++r){P0[r]=fsub_s(P0[r],dl);P1[r]=fsub_s(P1[r],dl);} \
      _Pragma("unroll") for(int r=0;r<16;++r)negm[r]=-mhat; asm volatile("":"+v"(negm)); } \
    _Pragma("unroll") for(int r=0;r<16;++r)P0[r]=__builtin_amdgcn_exp2f(P0[r]); }while(0)
  #define RESC() do{ if(resc){ asm volatile("s_waitcnt lgkmcnt(0)":::"memory"); \
      _Pragma("unroll") for(int d_=0;d_<2;++d_) _Pragma("unroll") for(int r=0;r<16;++r)o[d_][r]*=wsf[crow(r,hi)]; } }while(0)
  f32x16 pA0,pA1,pB0,pB1;
  int sl_prev=0,sl_cur=0,sl_next=SLOTB;
  #define ROT() do{sl_prev=sl_cur;sl_cur=sl_next;sl_next=(sl_next==(NSLOT-1)*SLOTB)?0:sl_next+SLOTB;}while(0)
  DMA_K(2,2*SLOTB);
  WAIT_BAR(3);
  qkt(pA0,pA1,Kbase,qr,negm,r32,hi);asm volatile("s_nop 15\n\ts_nop 7":"+v"(pA0),"+v"(pA1));CMASK(pA0,pA1,0);
  START(pA0,pA1);
  _Pragma("unroll") for(int r=0;r<16;++r)pA1[r]=__builtin_amdgcn_exp2f(pA1[r]);
  WAIT_BAR(0);
  DMA_K(3,0);DMA_V(1,SLOTB);
  ROT();
  kload8(kf,kp0+sl_cur);
  WAIT_BAR(2);
  s16x4 vlo[8],vhi[8]; u32x4 pw0,pw1,pw2,pw3;
  #define PKW(P,B) cvtpk_s(P[B],P[B+1])
  #define PAF(k) __builtin_bit_cast(bf16x8,pw##k)
  #define VFR(i) (bf16x8){vlo[i][0],vlo[i][1],vlo[i][2],vlo[i][3],vhi[i][0],vhi[i][1],vhi[i][2],vhi[i][3]}
  #define PIN(x) asm volatile("":"+v"(x))
  #define MX3(a,b,c) __builtin_fmaxf(__builtin_fmaxf((a),(b)),(c))
  #define GAPA(MF,A0,A1,A2,A3,W0,W1,PW) do{ MF; sacc+=A0; sacc+=A1; sacc+=A2; sacc+=A3; PIN(sacc); W0; W1; PIN(PW); SBAR(); }while(0)
  #define EX(v) __builtin_amdgcn_exp2f(v)
  #define GAPB(MF,X,B) do{ MF; X[B]=EX(X[B]); X[B+1]=EX(X[B+1]); X[B+2]=EX(X[B+2]); X[B+3]=EX(X[B+3]); PIN(X); SBAR(); }while(0)
  #define VRD(i) do{ vlo[i]=vtr(vp_+(((i)>>2)*4096+((i)&3)*1024)); vhi[i]=vtr(vp_+(((i)>>2)*4096+((i)&3)*1024+512)); }while(0)
  #define KRD(G,j) do{ if(G){ kload2(kf,kp0+sl_next,j); SBAR(); } }while(0)
  #define STEP(C0,C1,P0,P1,t,GK,GV,GL) do{ SBAR(); \
    const lds_cptr vp_=vp0+sl_prev; \
    VRD(0); SBAR(); float sacc=(P0[0]+P0[1]); \
    GAPA(C0=__builtin_amdgcn_mfma_f32_32x32x16_bf16(kf[0],qr[0],negm,0,0,0), P0[2],P0[3],P0[4],P0[5],     pw0[0]=PKW(P0,0), pw0[1]=PKW(P0,2), pw0); \
    VRD(4); SBAR(); GAPA(C1=__builtin_amdgcn_mfma_f32_32x32x16_bf16(kf[1],qr[0],negm,0,0,0), P0[6],P0[7],P0[8],P0[9],     pw0[2]=PKW(P0,4), pw0[3]=PKW(P0,6), pw0); \
    VRD(1); SBAR(); GAPA(C0=__builtin_amdgcn_mfma_f32_32x32x16_bf16(kf[2],qr[1],C0,0,0,0),   P0[10],P0[11],P0[12],P0[13], pw1[0]=PKW(P0,8), pw1[1]=PKW(P0,10), pw1); \
    VRD(5); SBAR(); GAPA(C1=__builtin_amdgcn_mfma_f32_32x32x16_bf16(kf[3],qr[1],C1,0,0,0),   P0[14],P0[15],P1[0],P1[1],   pw1[2]=PKW(P0,12),pw1[3]=PKW(P0,14), pw1); \
    VRD(2); SBAR(); GAPA(C0=__builtin_amdgcn_mfma_f32_32x32x16_bf16(kf[4],qr[2],C0,0,0,0),   P1[2],P1[3],P1[4],P1[5],     pw2[0]=PKW(P1,0), pw2[1]=PKW(P1,2), pw2); \
    VRD(6); SBAR(); GAPA(C1=__builtin_amdgcn_mfma_f32_32x32x16_bf16(kf[5],qr[2],C1,0,0,0),   P1[6],P1[7],P1[8],P1[9],     pw2[2]=PKW(P1,4), pw2[3]=PKW(P1,6), pw2); \
    VRD(3); SBAR(); GAPA(C0=__builtin_amdgcn_mfma_f32_32x32x16_bf16(kf[6],qr[3],C0,0,0,0),   P1[10],P1[11],P1[12],P1[13], pw3[0]=PKW(P1,8), pw3[1]=PKW(P1,10), pw3); \
    VRD(7); SBAR(); GAPA(C1=__builtin_amdgcn_mfma_f32_32x32x16_bf16(kf[7],qr[3],C1,0,0,0),   P1[14],P1[15],0.f,0.f,       pw3[2]=PKW(P1,12),pw3[3]=PKW(P1,14), pw3); \
    l_reg+=sacc; \
    if(GK){DMA_K((t)+3,sl_cur);} if(GV){DMA_V((t)+1,sl_next);} \
    CMASK(C0,C1,t); \
    { float a=MX3(C0[0],C0[1],C1[0]),b=MX3(C0[2],C0[3],C1[1]); a=MX3(a,C1[2],C1[3]); \
      _Pragma("unroll") for(int r=4;r<16;r+=4){a=MX3(a,C0[r],C0[r+1]);b=MX3(b,C0[r+2],C0[r+3]);a=MX3(a,C1[r],C1[r+1]);b=MX3(b,C1[r+2],C1[r+3]);} \
      float rm=__builtin_fmaxf(a,b); { auto rr=__builtin_amdgcn_permlane32_swap(__float_as_uint(rm),__float_as_uint(rm),false,false); rm=__builtin_fmaxf(__uint_as_float(rr[0]),__uint_as_float(rr[1])); } \
      resc=false; \
      if(__builtin_expect(__any(rm>(float)THRL),0)){ const float dl=__builtin_fmaxf(rm,0.f); mhat+=dl; \
        _Pragma("unroll") for(int r=0;r<16;++r){C0[r]-=dl;C1[r]-=dl;} \
        _Pragma("unroll") for(int r=0;r<16;++r)negm[r]=-mhat; asm volatile("":"+v"(negm)); \
        const float f=__builtin_amdgcn_exp2f(-dl); l_reg*=f; if(hi==0)wsf[r32]=f; resc=true; } } \
    SBAR(); \
    GAPB(o[0]=__builtin_amdgcn_mfma_f32_32x32x16_bf16(PAF(0),VFR(0),o[0],0,0,0), C0,0); \
    GAPB(o[1]=__builtin_amdgcn_mfma_f32_32x32x16_bf16(PAF(0),VFR(4),o[1],0,0,0), C0,4); \
    KRD(GL,0); GAPB(o[0]=__builtin_amdgcn_mfma_f32_32x32x16_bf16(PAF(1),VFR(1),o[0],0,0,0), C0,8); \
    KRD(GL,1); GAPB(o[1]=__builtin_amdgcn_mfma_f32_32x32x16_bf16(PAF(1),VFR(5),o[1],0,0,0), C0,12); \
    KRD(GL,2); GAPB(o[0]=__builtin_amdgcn_mfma_f32_32x32x16_bf16(PAF(2),VFR(2),o[0],0,0,0), C1,0); \
    KRD(GL,3); GAPB(o[1]=__builtin_amdgcn_mfma_f32_32x32x16_bf16(PAF(2),VFR(6),o[1],0,0,0), C1,4); \
    GAPB(o[0]=__builtin_amdgcn_mfma_f32_32x32x16_bf16(PAF(3),VFR(3),o[0],0,0,0), C1,8); \
    GAPB(o[1]=__builtin_amdgcn_mfma_f32_32x32x16_bf16(PAF(3),VFR(7),o[1],0,0,0), C1,12); \
    }while(0)
  int t=1;
  #undef CMASK
  #define CMASK(P0,P1,t) do{}while(0)
  for(;t+5<NT;t+=2){
    STEP(pB0,pB1,pA0,pA1,t,true,true,true);     WAIT_BAR(2); RESC(); ROT();
    STEP(pA0,pA1,pB0,pB1,t+1,true,true,true);   WAIT_BAR(2); RESC(); ROT();
  }
  #undef CMASK
  #define CMASK(P0,P1,t) do{int jb_=(t)-(NT-4); if(jb_>=0)cmask(P0,P1,jb_,qrel,hi);}while(0)
  #define ENDW(tt) do{ if((tt)+3<NT){WAIT_BAR(2);} else if((tt)+2<NT){WAIT_BAR(1);} else {WAIT_BAR(0);} }while(0)
  for(;t+1<NT;t+=2){
    STEP(pB0,pB1,pA0,pA1,t,(t+3<NT),(t+1<NT),(t+1<NT));       ENDW(t);   RESC(); ROT();
    STEP(pA0,pA1,pB0,pB1,t+1,(t+4<NT),(t+2<NT),(t+2<NT));     ENDW(t+1); RESC(); ROT();
  }
  STEP(pB0,pB1,pA0,pA1,NT-1,false,false,false); RESC();
  { float sacc=pB0[0]+pB0[1]; _Pragma("unroll") for(int r=2;r<16;++r)sacc+=pB0[r]; _Pragma("unroll") for(int r=0;r<16;++r)sacc+=pB1[r]; l_reg+=sacc;
    pw0=(u32x4){PKW(pB0,0),PKW(pB0,2),PKW(pB0,4),PKW(pB0,6)};pw1=(u32x4){PKW(pB0,8),PKW(pB0,10),PKW(pB0,12),PKW(pB0,14)};pw2=(u32x4){PKW(pB1,0),PKW(pB1,2),PKW(pB1,4),PKW(pB1,6)};pw3=(u32x4){PKW(pB1,8),PKW(pB1,10),PKW(pB1,12),PKW(pB1,14)};
    SBAR(); pv(o,vb0+sl_cur,PAF(0),PAF(1),PAF(2),PAF(3)); }
  #undef PKW
  #undef PAF
  #undef VFR
  #undef PIN
  #undef MX3
  #undef GAPA
  #undef GAPB
  #undef EX
  #undef VRD
  #undef KRD
  #undef STEP
  #undef ENDW
  {auto rr=__builtin_amdgcn_permlane32_swap(__float_as_uint(l_reg),__float_as_uint(l_reg),false,false);l_reg=__uint_as_float(rr[0])+__uint_as_float(rr[1]);}
  if(hi==0)wsf[32+r32]=l_reg;asm volatile("s_waitcnt lgkmcnt(0)":::"memory");
  float rli[16];
  #pragma unroll
  for(int r=0;r<16;++r)rli[r]=__builtin_amdgcn_rcpf(wsf[32+crow(r,hi)]);
  bf16*Ow=O+(rowbase+q0+wid*QBLK)*PO;
  { bf16*stg=(bf16*)(shm+LDS_OST)+wid*2048;
    #pragma unroll
    for(int r=0;r<16;++r){const int orow=crow(r,hi);
      #pragma unroll
      for(int d0=0;d0<2;++d0)stg[orow*64+d0*32+r32]=__float2bfloat16(o[d0][r]*rli[r]);}
    asm volatile("s_waitcnt lgkmcnt(0)":::"memory");
    #pragma unroll
    for(int i=0;i<4;++i){const int row=i*8+(lane>>3),ch=lane&7; const u32x4 v=*(const u32x4*)(stg+row*64+ch*8); ATTN_STORE16(Ow+(long)row*PO+ch*8,v);} }
  asm volatile("s_waitcnt lgkmcnt(0)\n\ts_barrier":::"memory");
  #undef DMA_K
  #undef DMA_V
  #undef CMASK
  #undef START
  #undef RESC
  #undef ROT
}
constexpr int ATTN_LDS_BYTES=LDS_BYTES;
#undef SBAR
#undef WAIT_BAR
}
constexpr int DM = 1024, NB = 8, SEQ = 8192, NTOK = NB * SEQ, NIN = 6144, NINP = 6272;
constexpr int C_HQ = 0, C_HF = 512, C_HI = 1024, C_HG = 1536, C_DQ = 2048, C_DK = 2560, C_DV = 3072, C_DG = 3584, C_MA = 4096, C_MB = 5120;
constexpr float RMS_EPS = 1e-6f;
constexpr float QSCALE = 0.125f * 1.4426950408889634f;
constexpr float LAM_INIT = 0.2f;
constexpr size_t MiB = 1u << 20;
constexpr size_t WS_ROWSQ = 20 * MiB  , WS_QCTR = 256 * 1024, WS_MOD = 512 * 1024, WS_WIN = 1 * MiB, WS_WAB = 13 * MiB, WS_WOUT = 15 * MiB, WS_XN = 32 * MiB, WS_PROJ = 160 * MiB, WS_END = 944 * MiB;
constexpr int LDS_BYTES = 147456;
constexpr int NTHR = 512;

typedef unsigned short bf16_t;
typedef short bf16x8 __attribute__((ext_vector_type(8)));
typedef float f32x4 __attribute__((ext_vector_type(4)));
typedef float f32x2 __attribute__((ext_vector_type(2)));
typedef unsigned u32x4 __attribute__((ext_vector_type(4)));
typedef unsigned u32x2 __attribute__((ext_vector_type(2)));

__device__ __forceinline__ float bf2f(unsigned h) { return __uint_as_float(h << 16); }
__device__ __forceinline__ unsigned f2bf(float f) { unsigned u = __float_as_uint(f); return (u + 0x7fffu + ((u >> 16) & 1u)) >> 16; }
__device__ __forceinline__ unsigned pk2(float lo, float hi) { return f2bf(lo) | (f2bf(hi) << 16); }
typedef __bf16 bf16x2_t_ __attribute__((ext_vector_type(2)));
__device__ __forceinline__ unsigned cvtpk(float lo, float hi) { const f32x2 v = {lo, hi}; return __builtin_bit_cast(unsigned, __builtin_convertvector(v, bf16x2_t_)); }
template <int CTRL> __device__ __forceinline__ float dpp_f(float v) { return __int_as_float(__builtin_amdgcn_update_dpp(0, __float_as_int(v), CTRL, 0xf, 0xf, true)); }
template <int M> __device__ __forceinline__ float swz_xor(float v) { return __int_as_float(__builtin_amdgcn_ds_swizzle(__float_as_int(v), (M << 10) | 0x1f)); }
__device__ __forceinline__ float half_sum(float v) { auto rr = __builtin_amdgcn_permlane32_swap(__float_as_uint(v), __float_as_uint(v), false, false); return __uint_as_float(rr[0]) + __uint_as_float(rr[1]); }
__device__ __forceinline__ float wave_sum(float v) { v += swz_xor<1>(v); v += swz_xor<2>(v); v += swz_xor<4>(v); v += swz_xor<8>(v); v += swz_xor<16>(v); return half_sum(v); }
__device__ __forceinline__ float sigmoidf_(float v) { return 1.0f / (1.0f + __expf(-v)); }

struct Params { const float* in[17]; float* out; unsigned char* ws; };
enum { I_X = 0, I_C, I_WADA, I_BADA, I_GPRE, I_GPOST, I_WIN, I_LB, I_HGG, I_LQ1, I_LK1, I_LQ2, I_LK2, I_DNG, I_WA, I_WB, I_WOUT };

struct Ctx {
    unsigned char* lds; int tid, lane, wave, vcu, G;
    bf16_t *WIN, *WAB, *WOUT, *XN, *PROJ, *OAB, *OB4;
    float *ROWSQ, *MOD, *OARAW;
};

__device__ __forceinline__ void transpose_item(const float* __restrict__ W, int N, bf16_t* WT, int ldt, int koff, float* scr, int item, int lane) {
    const int nblk = N / 32, kb = item / nblk, nb = item % nblk, k0 = 64 * kb, n0 = 32 * nb;
#pragma unroll 8
    for (int i = 0; i < 32; ++i) { const int kk = 2 * i + (lane >> 5); scr[kk * 33 + (lane & 31)] = W[(size_t)(k0 + kk) * N + n0 + (lane & 31)]; }
    asm volatile("s_waitcnt lgkmcnt(0)" ::: "memory");
    const int c = lane & 7;
#pragma unroll
    for (int j = 0; j < 4; ++j) { const int n = (lane >> 3) + 8 * j; const float* s = scr + (8 * c) * 33 + n;
        u32x4 o; o.x = pk2(s[0 * 33], s[1 * 33]); o.y = pk2(s[2 * 33], s[3 * 33]); o.z = pk2(s[4 * 33], s[5 * 33]); o.w = pk2(s[6 * 33], s[7 * 33]);
        *(u32x4*)(WT + (size_t)(n0 + n) * ldt + koff + k0 + 8 * c) = o; }
    asm volatile("s_waitcnt lgkmcnt(0)" ::: "memory");
}

__device__ __forceinline__ void phase_prologue(const Params& P, const Ctx& C) {
    if (C.vcu < 48) {
        float* sc = (float*)(C.lds + 69632); float* red = (float*)(C.lds + 102400);
        const float* cc = P.in[I_C];
        for (int i = C.tid; i < NB * DM; i += NTHR) { const float v = cc[i]; sc[i] = v * sigmoidf_(v); }
        __syncthreads();
        const int n = C.vcu * 64 + C.lane; const float* wa = P.in[I_WADA];
        float acc[NB];
#pragma unroll
        for (int b = 0; b < NB; ++b) acc[b] = 0.f;
#pragma unroll 16
        for (int kk = 0; kk < 128; ++kk) { const int k = C.wave * 128 + kk; const float w = wa[(size_t)k * 3072 + n];
#pragma unroll
            for (int b = 0; b < NB; ++b) acc[b] += sc[b * DM + k] * w; }
#pragma unroll
        for (int b = 0; b < NB; ++b) red[(C.wave * NB + b) * 64 + C.lane] = acc[b];
        __syncthreads();
        { const int bb = C.tid >> 6; float s = 0.f;
#pragma unroll
          for (int w = 0; w < 8; ++w) s += red[(w * NB + bb) * 64 + C.lane];
          C.MOD[bb * 3072 + n] = s + P.in[I_BADA][n]; }
        __syncthreads();
    }
    float* scr = (float*)(C.lds + C.wave * 8448);
    const bool split = C.G > 96; const int gw = split ? (C.vcu - 48) * 8 + C.wave : C.vcu * 8 + C.wave, NGW = split ? (C.G - 48) * 8 : C.G * 8;
    constexpr int IT_IN = 16 * 192, IT_A = 8 * 32, IT_B = 8 * 32, IT_O = 16 * 32;
    for (int it = (split && C.vcu < 48) ? IT_IN + IT_A + IT_B + IT_O : gw; it < IT_IN + IT_A + IT_B + IT_O; it += NGW) {
        int r = it;
        if (r < IT_IN) { transpose_item(P.in[I_WIN], NIN, C.WIN, DM, 0, scr, r, C.lane); continue; } r -= IT_IN;
        if (r < IT_A) { transpose_item(P.in[I_WA], DM, C.WAB, DM, 0, scr, r, C.lane); continue; } r -= IT_A;
        if (r < IT_B) { transpose_item(P.in[I_WB], DM, C.WAB, DM, 512, scr, r, C.lane); continue; } r -= IT_B;
        transpose_item(P.in[I_WOUT], DM, C.WOUT, DM, 0, scr, r, C.lane);
    }
    if (blockIdx.x == 2) {
        float* aux = C.MOD + 24576;
        if (C.wave == 0) { const float lam = __expf(wave_sum(P.in[I_LQ1][C.lane] * P.in[I_LK1][C.lane])) - __expf(wave_sum(P.in[I_LQ2][C.lane] * P.in[I_LK2][C.lane])) + LAM_INIT; if (C.lane == 0) aux[0] = lam; }
        aux[64 + C.tid] = P.in[I_DNG][C.tid];
    }

}

__device__ __forceinline__ void phase_prenorm(const Params& P, const Ctx& C) {
    const int gw = C.vcu * 8 + C.wave, NGW = C.G * 8;
    const float* gp = P.in[I_GPRE];
    for (int m4 = gw; m4 < NTOK / 4; m4 += NGW) {
        const int m = m4 * 4, b = m >> 13;
        const f32x4* xr = (const f32x4*)(P.in[I_X] + (size_t)m * DM) + C.lane;
        f32x4 v[16]; float ss[4];
#pragma unroll
        for (int j = 0; j < 16; ++j) v[j] = __builtin_nontemporal_load(xr + 64 * j);
#pragma unroll
        for (int r = 0; r < 4; ++r) { float a = 0.f;
#pragma unroll
            for (int j = 0; j < 4; ++j) { const f32x4 t = v[4 * r + j]; a += (t.x * t.x + t.y * t.y) + (t.z * t.z + t.w * t.w); }
            ss[r] = rsqrtf(wave_sum(a) * (1.f / DM) + RMS_EPS); }
        u32x2* o8 = (u32x2*)(C.XN + (size_t)m * DM) + C.lane;
#pragma unroll
        for (int j = 0; j < 4; ++j) { const int idx = (C.lane + 64 * j) * 4;
            const f32x4 g = *(const f32x4*)(gp + idx), sh = *(const f32x4*)(C.MOD + b * 3072 + idx), sc = *(const f32x4*)(C.MOD + b * 3072 + 1024 + idx);
            const f32x4 gs = g * (sc + 1.0f);
#pragma unroll
            for (int r = 0; r < 4; ++r) { const f32x4 h = v[4 * r + j] * ss[r] * gs + sh;
                u32x2 o; o.x = cvtpk(h.x, h.y); o.y = cvtpk(h.z, h.w); o8[r * 256 + 64 * j] = o; } }
    }
}

template <class Epi>
__device__ __forceinline__ void gemm_simple(const bf16_t* __restrict__ A, int lda, const bf16_t* __restrict__ Bt, int ldb, int M, int N, int K, const Ctx& C, const Epi& E) {
    const int fr = C.lane & 15, fq = C.lane >> 4, wm = C.wave >> 2, wn = C.wave & 3;
    const int ntn = N / 256, ntiles = (M / 128) * ntn;
    for (int tile = C.vcu; tile < ntiles; tile += C.G) {
        const int tm = tile / ntn, tn = tile % ntn, m0 = tm * 128 + wm * 64, n0 = tn * 256 + wn * 64;
        f32x4 acc[4][4];
#pragma unroll
        for (int i = 0; i < 4; ++i)
#pragma unroll
            for (int j = 0; j < 4; ++j) acc[i][j] = (f32x4){0.f, 0.f, 0.f, 0.f};
        const bf16_t* ap = A + (size_t)(m0 + fr) * lda + fq * 8; const bf16_t* bp = Bt + (size_t)(n0 + fr) * ldb + fq * 8;
        for (int k0 = 0; k0 < K; k0 += 32) {
            if (Epi::MID) { if (k0 == K / 2) E.mid(acc, m0, n0, fr, fq); }
            bf16x8 a[4], b[4];
#pragma unroll
            for (int i = 0; i < 4; ++i) { a[i] = *(const bf16x8*)(ap + (size_t)i * 16 * lda + k0); b[i] = *(const bf16x8*)(bp + (size_t)i * 16 * ldb + k0); }
#pragma unroll
            for (int mi = 0; mi < 4; ++mi)
#pragma unroll
                for (int ni = 0; ni < 4; ++ni) acc[mi][ni] = __builtin_amdgcn_mfma_f32_16x16x32_bf16(b[ni], a[mi], acc[mi][ni], 0, 0, 0);
        }
        E(acc, m0, n0, fr, fq);
    }
}
struct EpiProj {
    static constexpr bool MID = false; bf16_t* O;
    __device__ __forceinline__ void mid(f32x4 (&)[4][4], int, int, int, int) const {}
    __device__ __forceinline__ void operator()(const f32x4 (&acc)[4][4], int m0, int n0, int fr, int fq) const {
        const float sc = (n0 >= C_DQ && n0 < C_DK) ? QSCALE : 1.0f;
#pragma unroll
        for (int mi = 0; mi < 4; ++mi)
#pragma unroll
            for (int ni = 0; ni < 4; ++ni) { const f32x4 v = acc[mi][ni] * sc; u32x2 o; o.x = pk2(v.x, v.y); o.y = pk2(v.z, v.w);
                *(u32x2*)(O + (size_t)(m0 + 16 * mi + fr) * NINP + n0 + 16 * ni + 4 * fq) = o; }
    }
};
struct EpiMerge {
    static constexpr bool MID = true; const bf16_t* PROJ; bf16_t* Y;
    __device__ __forceinline__ void mid(f32x4 (&acc)[4][4], int m0, int n0, int fr, int fq) const {
#pragma unroll
        for (int mi = 0; mi < 4; ++mi)
#pragma unroll
            for (int ni = 0; ni < 4; ++ni) { const bf16_t* p = PROJ + (size_t)(m0 + 16 * mi + fr) * NINP + n0 + 16 * ni + 4 * fq;
                const u32x2 a = *(const u32x2*)(p + C_MA), b = *(const u32x2*)(p + C_MB);
                const float a0 = bf2f(a.x & 0xffffu), a1 = bf2f(a.x >> 16), a2 = bf2f(a.y & 0xffffu), a3 = bf2f(a.y >> 16);
                const float b0 = bf2f(b.x & 0xffffu), b1 = bf2f(b.x >> 16), b2 = bf2f(b.y & 0xffffu), b3 = bf2f(b.y >> 16);
                f32x4 r; r.x = (1.f + __expf(-b0)) / (1.f + __expf(-a0)); r.y = (1.f + __expf(-b1)) / (1.f + __expf(-a1));
                r.z = (1.f + __expf(-b2)) / (1.f + __expf(-a2)); r.w = (1.f + __expf(-b3)) / (1.f + __expf(-a3));
                acc[mi][ni] = acc[mi][ni] * r; }
    }
    __device__ __forceinline__ void operator()(const f32x4 (&acc)[4][4], int m0, int n0, int fr, int fq) const {
#pragma unroll
        for (int mi = 0; mi < 4; ++mi)
#pragma unroll
            for (int ni = 0; ni < 4; ++ni) { const size_t off = (size_t)(m0 + 16 * mi + fr) * NINP + n0 + 16 * ni + 4 * fq;
                const u32x2 b = *(const u32x2*)(PROJ + off + C_MB);
                f32x4 s; s.x = sigmoidf_(bf2f(b.x & 0xffffu)); s.y = sigmoidf_(bf2f(b.x >> 16)); s.z = sigmoidf_(bf2f(b.y & 0xffffu)); s.w = sigmoidf_(bf2f(b.y >> 16));
                const f32x4 v = acc[mi][ni] * s; u32x2 o; o.x = pk2(v.x, v.y); o.y = pk2(v.z, v.w);
                *(u32x2*)(Y + off) = o; }
    }
};
struct EpiZ {
    static constexpr bool MID = false; float* Z; float* ROWSQ;
    __device__ __forceinline__ void mid(f32x4 (&)[4][4], int, int, int, int) const {}
    __device__ __forceinline__ void operator()(const f32x4 (&acc)[4][4], int m0, int n0, int fr, int fq) const {
#pragma unroll
        for (int mi = 0; mi < 4; ++mi) { float s = 0.f;
#pragma unroll
            for (int ni = 0; ni < 4; ++ni) { const f32x4 v = acc[mi][ni]; s += (v.x * v.x + v.y * v.y) + (v.z * v.z + v.w * v.w);
                *(f32x4*)(Z + (size_t)(m0 + 16 * mi + fr) * DM + n0 + 16 * ni + 4 * fq) = v; }
            s += swz_xor<16>(s); s = half_sum(s);
            if (fq == 0) atomicAdd(ROWSQ + m0 + 16 * mi + fr, s); }
    }
};


struct EpiProj2 {
    static constexpr bool PERM = true, AFTER_DRAIN = false, MID = false, POST = false; bf16_t* O; bf16_t* KH; bf16_t* VH;
    __device__ __forceinline__ void mid(f32x4 (&)[2][2][4][2], const pg8::Unit&, int, int, int, int) const {}
    __device__ __forceinline__ void operator()(const f32x4 (&acc)[2][2][4][2], const pg8::Unit& u, int wr, int wc, int fr, int fq) const {
        const float sc = (u.pn == 8 || u.pn == 9) ? QSCALE : 1.0f;
        const bool gate = u.pn >= 16;
        const int row0 = u.pm * 256 + wr * 64 + fr, col0 = u.pn * 256 + wc * 32 + 8 * fq;
        if (u.pn >= 10 && u.pn < 14) {
            const bool isk = u.pn < 12; const int b = row0 >> 13, t0 = row0 & (SEQ - 1);
#pragma unroll
            for (int bj = 0; bj < 2; ++bj) { const int c = col0 + bj * 128 - (isk ? C_DK : C_DV);
                bf16_t* hp = isk ? KH + ((size_t)(b * 8 + (c >> 6)) * SEQ + t0) * 64 + (c & 63) : VH + ((size_t)(b * 4 + (c >> 7)) * SEQ + t0) * 128 + (c & 127);
                const int pitch = isk ? 64 : 128;
#pragma unroll
                for (int ai = 0; ai < 2; ++ai)
#pragma unroll
                    for (int m = 0; m < 4; ++m) { const f32x4 v0 = acc[ai][bj][m][0], v1 = acc[ai][bj][m][1];
                        u32x4 w; w.x = cvtpk(v0[0], v0[1]); w.y = cvtpk(v0[2], v0[3]); w.z = cvtpk(v1[0], v1[1]); w.w = cvtpk(v1[2], v1[3]);
                        *(u32x4*)(hp + (size_t)(ai * 128 + m * 16) * pitch) = w; } }
            return;
        }
#pragma unroll
        for (int ai = 0; ai < 2; ++ai)
#pragma unroll
            for (int m = 0; m < 4; ++m) { bf16_t* rowp = O + (size_t)(row0 + ai * 128 + m * 16) * NINP + col0;
#pragma unroll
                for (int bj = 0; bj < 2; ++bj) { f32x4 v0 = acc[ai][bj][m][0] * sc, v1 = acc[ai][bj][m][1] * sc;
                    if (gate) {
#pragma unroll
                        for (int i = 0; i < 4; ++i) { v0[i] = 1.0f + __expf(-fminf(fmaxf(v0[i], -60.f), 60.f)); v1[i] = 1.0f + __expf(-fminf(fmaxf(v1[i], -60.f), 60.f)); } }
                    u32x4 w; w.x = cvtpk(v0[0], v0[1]); w.y = cvtpk(v0[2], v0[3]); w.z = cvtpk(v1[0], v1[1]); w.w = cvtpk(v1[2], v1[3]);
                    *(u32x4*)(rowp + bj * 128) = w; } }
    }
};
__device__ __forceinline__ void unpack8(const u32x4 a, float (&f)[8]) {
    f[0] = bf2f(a.x & 0xffffu); f[1] = bf2f(a.x >> 16); f[2] = bf2f(a.y & 0xffffu); f[3] = bf2f(a.y >> 16);
    f[4] = bf2f(a.z & 0xffffu); f[5] = bf2f(a.z >> 16); f[6] = bf2f(a.w & 0xffffu); f[7] = bf2f(a.w >> 16);
}
struct EpiMerge2 {
    static constexpr bool PERM = true, AFTER_DRAIN = false, MID = true, POST = false; const bf16_t* PROJ; bf16_t* Y;
    __device__ __forceinline__ void mid(f32x4 (&acc)[2][2][4][2], const pg8::Unit& u, int wr, int wc, int fr, int fq) const {
        asm volatile("" : "+v"(fr), "+v"(fq));
        const int row0 = u.pm * 256 + wr * 64 + fr, col0 = u.pn * 256 + wc * 32 + 8 * fq;
#pragma unroll
        for (int ai = 0; ai < 2; ++ai)
#pragma unroll
            for (int m = 0; m < 4; ++m) { const bf16_t* rowp = PROJ + (size_t)(row0 + ai * 128 + m * 16) * NINP + col0;
#pragma unroll
                for (int bj = 0; bj < 2; ++bj) { float a[8], b[8]; unpack8(*(const u32x4*)(rowp + C_MA + bj * 128), a); unpack8(*(const u32x4*)(rowp + C_MB + bj * 128), b);
                    float r[8];
#pragma unroll
                    for (int i = 0; i < 8; ++i) r[i] = b[i] * __builtin_amdgcn_rcpf(a[i]);
                    acc[ai][bj][m][0] = acc[ai][bj][m][0] * (f32x4){r[0], r[1], r[2], r[3]}; acc[ai][bj][m][1] = acc[ai][bj][m][1] * (f32x4){r[4], r[5], r[6], r[7]}; }
                asm volatile("" : "+v"(acc[ai][0][m][0]), "+v"(acc[ai][0][m][1]), "+v"(acc[ai][1][m][0]), "+v"(acc[ai][1][m][1]) :: "memory"); }
    }
    __device__ __forceinline__ void operator()(const f32x4 (&acc)[2][2][4][2], const pg8::Unit& u, int wr, int wc, int fr, int fq) const {
        asm volatile("" : "+v"(fr), "+v"(fq));
        const int row0 = u.pm * 256 + wr * 64 + fr, col0 = u.pn * 256 + wc * 32 + 8 * fq;
#pragma unroll
        for (int ai = 0; ai < 2; ++ai)
#pragma unroll
            for (int m = 0; m < 4; ++m) { const size_t off = (size_t)(row0 + ai * 128 + m * 16) * NINP + col0;
#pragma unroll
                for (int bj = 0; bj < 2; ++bj) { float b[8]; unpack8(*(const u32x4*)(PROJ + off + C_MB + bj * 128), b);
#pragma unroll
                    for (int i = 0; i < 8; ++i) b[i] = __builtin_amdgcn_rcpf(b[i]);
                    const f32x4 v0 = acc[ai][bj][m][0] * (f32x4){b[0], b[1], b[2], b[3]}, v1 = acc[ai][bj][m][1] * (f32x4){b[4], b[5], b[6], b[7]};
                    u32x4 w; w.x = cvtpk(v0[0], v0[1]); w.y = cvtpk(v0[2], v0[3]); w.z = cvtpk(v1[0], v1[1]); w.w = cvtpk(v1[2], v1[3]);
                    *(u32x4*)(Y + (size_t)(row0 + ai * 128 + m * 16) * DM + col0 + bj * 128) = w; }
                asm volatile("" ::: "memory"); }
    }
};
struct EpiZ2 {
    static constexpr bool PERM = true, AFTER_DRAIN = false, MID = false, POST = false; bf16_t* ZB; float* ROWSQ;
    __device__ __forceinline__ void mid(f32x4 (&)[2][2][4][2], const pg8::Unit&, int, int, int, int) const {}
    __device__ __forceinline__ void operator()(const f32x4 (&acc)[2][2][4][2], const pg8::Unit& u, int wr, int wc, int fr, int fq) const {
        const int row0 = u.pm * 256 + wr * 64 + fr, col0 = u.pn * 256 + wc * 32 + 8 * fq;
#pragma unroll
        for (int ai = 0; ai < 2; ++ai)
#pragma unroll
            for (int m = 0; m < 4; ++m) { const int row = row0 + ai * 128 + m * 16; float s = 0.f;
#pragma unroll
                for (int bj = 0; bj < 2; ++bj) { const f32x4 v0 = acc[ai][bj][m][0], v1 = acc[ai][bj][m][1];
                    s += ((v0.x * v0.x + v0.y * v0.y) + (v0.z * v0.z + v0.w * v0.w)) + ((v1.x * v1.x + v1.y * v1.y) + (v1.z * v1.z + v1.w * v1.w));
                    u32x4 w; w.x = cvtpk(v0[0], v0[1]); w.y = cvtpk(v0[2], v0[3]); w.z = cvtpk(v1[0], v1[1]); w.w = cvtpk(v1[2], v1[3]);
                    *(u32x4*)(ZB + (size_t)row * NINP + col0 + bj * 128) = w; }
                s += swz_xor<16>(s); s = half_sum(s);
                if (fq == 0) ROWSQ[(size_t)row * 16 + u.pn * 4 + wc] = s; }
    }
};

__device__ __forceinline__ void phase_hgrn_naive(const Params& P, const Ctx& C) {
    float* qs = (float*)C.lds; float* fs = qs + 8192; float* ks = fs + 8192; float* vs = ks + 8192; float* part = vs + 1024; float* lbs = part + 8192;
    const int e = C.tid & 15, dg = C.tid >> 4;
    for (int unit = C.vcu; unit < 256; unit += C.G) {
        const int b = unit >> 5, h = (unit >> 3) & 3, es = unit & 7;
        __syncthreads();
        if (C.tid < 128) { const float l0 = P.in[I_LB][h * 128 + C.tid], l1 = P.in[I_LB][512 + h * 128 + C.tid]; lbs[C.tid] = 1.0f / (1.0f + __expf(l1 - l0)); }
        __syncthreads();
        float S0 = 0.f, S1 = 0.f, S2 = 0.f, S3 = 0.f;
        for (int c = 0; c < SEQ / 64; ++c) {
            const size_t row0 = (size_t)b * SEQ + c * 64;
#pragma unroll 4
            for (int j = 0; j < 16; ++j) { const int idx = C.tid + NTHR * j, t = idx >> 7, d = idx & 127;
                const bf16_t* p = C.PROJ + (row0 + t) * NINP + h * 128 + d;
                const float q = bf2f(p[C_HQ]), fz = bf2f(p[C_HF]), sg = sigmoidf_(fz), lb = lbs[d];
                qs[idx] = q; fs[idx] = lb + (1.f - lb) * sg; ks[idx] = (1.f - lb) * sigmoidf_(-fz); }
#pragma unroll
            for (int j = 0; j < 2; ++j) { const int idx = C.tid + NTHR * j, t = idx >> 4, ee = idx & 15;
                vs[idx] = bf2f(C.PROJ[(row0 + t) * NINP + C_HI + h * 128 + es * 16 + ee]); }
            __syncthreads();
            for (int t = 0; t < 64; ++t) {
                const f32x4 f4 = *(const f32x4*)(fs + t * 128 + dg * 4), k4 = *(const f32x4*)(ks + t * 128 + dg * 4), q4 = *(const f32x4*)(qs + t * 128 + dg * 4);
                const float v = vs[t * 16 + e];
                S0 = f4.x * S0 + k4.x * v; S1 = f4.y * S1 + k4.y * v; S2 = f4.z * S2 + k4.z * v; S3 = f4.w * S3 + k4.w * v;
                float po = (S0 * q4.x + S1 * q4.y) + (S2 * q4.z + S3 * q4.w);
                po += swz_xor<16>(po); po = half_sum(po);
                if (C.lane < 16) part[(t * 8 + C.wave) * 16 + C.lane] = po;
            }
            __syncthreads();
#pragma unroll
            for (int j = 0; j < 2; ++j) { const int idx = C.tid + NTHR * j, t = idx >> 4, ee = idx & 15; float s = 0.f;
#pragma unroll
                for (int w = 0; w < 8; ++w) s += part[(t * 8 + w) * 16 + ee];
                C.OARAW[(row0 + t) * 512 + h * 128 + es * 16 + ee] = s; }
            __syncthreads();
        }
    }
}


constexpr int HG_QH = 0, HG_KH = 17408, HG_KT = 34816, HG_VT = 53248, HG_PS = 71680, HG_ST = 80896, HG_SEG = 115712, HG_E31 = 117760, HG_E63 = 118272, HG_ROWP = 118784;
constexpr int HG_RQ = HG_PS, HG_RF = HG_PS + 16384, HG_RV = HG_QH, HG_RG = 120832;
static_assert(HG_RF + 16384 <= HG_SEG && 16384 <= HG_KH - HG_QH && HG_RG + 16384 <= LDS_BYTES - 64, "raw tile aliases");
#define HG_BAR() do { asm volatile("s_waitcnt lgkmcnt(0)" ::: "memory"); __builtin_amdgcn_s_barrier(); asm volatile("" ::: "memory"); } while (0)
__device__ __forceinline__ void hgrn_chain(const Params& P, const Ctx& C, int b, int h) {
    unsigned char* L = C.lds;
    int tid_ = C.tid; asm volatile("" : "+v"(tid_));
    const int tid = tid_, lane = tid & 63, w = C.wave, fr = lane & 15, fq = lane >> 4, col = tid & 127, seg = tid >> 7;
    bf16_t* QH = (bf16_t*)(L + HG_QH); bf16_t* KH = (bf16_t*)(L + HG_KH); bf16_t* KT = (bf16_t*)(L + HG_KT); bf16_t* VT = (bf16_t*)(L + HG_VT);
    bf16_t* PS = (bf16_t*)(L + HG_PS); bf16_t* STw = (bf16_t*)(L + HG_ST + w * 4352);
    const bf16_t* RQ = (const bf16_t*)(L + HG_RQ); const bf16_t* RF = (const bf16_t*)(L + HG_RF); const bf16_t* RV = (const bf16_t*)(L + HG_RV); const bf16_t* RG = (const bf16_t*)(L + HG_RG);
    float* SEG = (float*)(L + HG_SEG); float* E31 = (float*)(L + HG_E31); float* E63 = (float*)(L + HG_E63); float* ROWT = (float*)(L + HG_ROWP);
    const float lb = 1.0f / (1.0f + __expf(P.in[I_LB][512 + h * 128 + col] - P.in[I_LB][h * 128 + col]));
#define omlb (1.0f - lb)
    const bf16_t* base = C.PROJ + (size_t)b * SEQ * NINP + h * 128;
    bf16_t* obase = C.OAB + (size_t)b * SEQ * DM + h * 128;
    f32x4 Sacc[8];
#pragma unroll
    for (int j = 0; j < 8; ++j) Sacc[j] = (f32x4){0.f, 0.f, 0.f, 0.f};
    const int r0 = tid >> 4, pc = (tid & 15) * 8;
    u32x4 pq[1][2], pf[1][2], pv[1][2], pg[1][2];
    int loff = r0 * NINP + pc;
#define HG_LOAD(s_, c_) do { const bf16_t* p_ = base + (size_t)(c_) * 64 * NINP; _Pragma("unroll") for (int k_ = 0; k_ < 2; ++k_) { const bf16_t* q_ = p_ + (loff + k_ * 32 * NINP); \
        pq[s_][k_] = *(const u32x4*)(q_ + C_HQ); pf[s_][k_] = *(const u32x4*)(q_ + C_HF); pv[s_][k_] = *(const u32x4*)(q_ + C_HI); pg[s_][k_] = *(const u32x4*)(q_ + C_HG); } } while (0)
    HG_LOAD(0, 0);
    for (int c = 0; c < SEQ / 64; ++c) {
      { constexpr int hs = 0;
        const int row0 = c * 64;
#pragma unroll
        for (int k = 0; k < 2; ++k) { const int o_ = (r0 + 32 * k) * 128 + pc;
            *(u32x4*)(L + HG_RQ + o_ * 2) = pq[hs][k]; *(u32x4*)(L + HG_RF + o_ * 2) = pf[hs][k]; *(u32x4*)(L + HG_RV + o_ * 2) = pv[hs][k]; *(u32x4*)(L + HG_RG + o_ * 2) = pg[hs][k]; }
        if (c + 1 < SEQ / 64) { asm volatile("" : "+v"(loff)); HG_LOAD(hs, c + 1); }
        HG_BAR();
        float sgv[16]; float run = 1.f;
        { unsigned vt[8];
#pragma unroll
          for (int i = 0; i < 16; ++i) { const int ro = (16 * seg + i) * 128 + col; float fz = bf2f(RF[ro]); fz = fminf(fmaxf(fz, -30.f), 30.f);
              const float sg = __builtin_amdgcn_rcpf(1.f + __expf(-fz));
              sgv[i] = sg; run *= (lb + omlb * sg);
              const unsigned v = RV[ro]; if (i & 1) vt[i >> 1] |= v << 16; else vt[i >> 1] = v; }
          *(u32x4*)(VT + col * 72 + seg * 16) = (u32x4){vt[0], vt[1], vt[2], vt[3]}; *(u32x4*)(VT + col * 72 + seg * 16 + 8) = (u32x4){vt[4], vt[5], vt[6], vt[7]}; }
        SEG[seg * 128 + col] = run;
        if (tid < 64) ROWT[tid] = 0.f;
        HG_BAR();
        { const float s0 = SEG[col], s1 = SEG[128 + col], s2 = SEG[256 + col], s3 = SEG[384 + col];
          const float p31 = s0 * s1, p6331 = s2 * s3;
          float g = (seg == 0) ? __builtin_amdgcn_rcpf(p31) : (seg == 1) ? __builtin_amdgcn_rcpf(s1) : (seg == 2) ? 1.0f : s2;
          unsigned kt[8];
#pragma unroll
          for (int i = 0; i < 16; i += 2) {
              g *= (lb + omlb * sgv[i]); const float g0 = g; g *= (lb + omlb * sgv[i + 1]); const float g1 = g;
              const float kh0 = (omlb - omlb * sgv[i]) * __builtin_amdgcn_rcpf(g0), kh1 = (omlb - omlb * sgv[i + 1]) * __builtin_amdgcn_rcpf(g1);
              const unsigned qw = cvtpk(bf2f(RQ[(16 * seg + i) * 128 + col]) * g0, bf2f(RQ[(16 * seg + i + 1) * 128 + col]) * g1), kw = cvtpk(kh0, kh1);
              QH[(16 * seg + i) * 136 + col] = (bf16_t)(qw & 0xffffu); QH[(16 * seg + i + 1) * 136 + col] = (bf16_t)(qw >> 16);
              KH[(16 * seg + i) * 136 + col] = (bf16_t)(kw & 0xffffu); KH[(16 * seg + i + 1) * 136 + col] = (bf16_t)(kw >> 16);
              kt[i >> 1] = cvtpk(kh0 * p6331, kh1 * p6331); }
          *(u32x4*)(KT + col * 72 + seg * 16) = (u32x4){kt[0], kt[1], kt[2], kt[3]}; *(u32x4*)(KT + col * 72 + seg * 16 + 8) = (u32x4){kt[4], kt[5], kt[6], kt[7]};
          if (seg == 0) { E31[col] = p31; E63[col] = p31 * p6331; } }
        HG_BAR();
#pragma unroll
        for (int j = 0; j < 8; ++j) { const float ev = E31[16 * j + fr];
#pragma unroll
            for (int i = 0; i < 4; i += 2) { const unsigned sw = cvtpk(Sacc[j][i] * ev, Sacc[j][i + 1] * ev);
                STw[(4 * fq + i) * 136 + 16 * j + fr] = (bf16_t)(sw & 0xffffu); STw[(4 * fq + i + 1) * 136 + 16 * j + fr] = (bf16_t)(sw >> 16); } }
#pragma unroll
        for (int q = 0; q < 2; ++q) { const int tt = 2 * w + q, ti = tt >> 2, sj = tt & 3; f32x4 pa = (f32x4){0.f, 0.f, 0.f, 0.f};
            if (sj <= ti) {
#pragma unroll
                for (int k4 = 0; k4 < 4; ++k4) { const bf16x8 a = *(const bf16x8*)(QH + (16 * ti + fr) * 136 + 32 * k4 + 8 * fq), bb = *(const bf16x8*)(KH + (16 * sj + fr) * 136 + 32 * k4 + 8 * fq);
                    pa = __builtin_amdgcn_mfma_f32_16x16x32_bf16(a, bb, pa, 0, 0, 0); }
                if (sj == ti) {
#pragma unroll
                    for (int i = 0; i < 4; ++i) if (fr > 4 * fq + i) pa[i] = 0.f; }
            }
            const unsigned w0 = cvtpk(pa[0], pa[1]), w1 = cvtpk(pa[2], pa[3]); bf16_t* pp = PS + (16 * ti + 4 * fq) * 72 + 16 * sj + fr;
            pp[0] = (bf16_t)(w0 & 0xffffu); pp[72] = (bf16_t)(w0 >> 16); pp[144] = (bf16_t)(w1 & 0xffffu); pp[216] = (bf16_t)(w1 >> 16); }
        f32x4 o[4];
#pragma unroll
        for (int mt = 0; mt < 4; ++mt) o[mt] = (f32x4){0.f, 0.f, 0.f, 0.f};
#pragma unroll
        for (int k4 = 0; k4 < 4; ++k4) { const bf16x8 bs = *(const bf16x8*)(STw + fr * 136 + 32 * k4 + 8 * fq);
#pragma unroll
            for (int mt = 0; mt < 4; ++mt) { const bf16x8 a = *(const bf16x8*)(QH + (16 * mt + fr) * 136 + 32 * k4 + 8 * fq); o[mt] = __builtin_amdgcn_mfma_f32_16x16x32_bf16(a, bs, o[mt], 0, 0, 0); } }
        HG_BAR();
        bf16x8 vf[2];
#pragma unroll
        for (int k2 = 0; k2 < 2; ++k2) vf[k2] = *(const bf16x8*)(VT + (16 * w + fr) * 72 + 32 * k2 + 8 * fq);
#pragma unroll
        for (int k2 = 0; k2 < 2; ++k2)
#pragma unroll
            for (int mt = 0; mt < 4; ++mt) { if (k2 == 1 && mt < 2) continue;
                const bf16x8 a = *(const bf16x8*)(PS + (16 * mt + fr) * 72 + 32 * k2 + 8 * fq); o[mt] = __builtin_amdgcn_mfma_f32_16x16x32_bf16(a, vf[k2], o[mt], 0, 0, 0); }
#pragma unroll
        for (int j = 0; j < 8; ++j) { const float ev = E63[16 * j + fr]; Sacc[j] = Sacc[j] * ev;
#pragma unroll
            for (int k2 = 0; k2 < 2; ++k2) { const bf16x8 bk = *(const bf16x8*)(KT + (16 * j + fr) * 72 + 32 * k2 + 8 * fq); Sacc[j] = __builtin_amdgcn_mfma_f32_16x16x32_bf16(vf[k2], bk, Sacc[j], 0, 0, 0); } }
#pragma unroll
        for (int mt = 0; mt < 4; ++mt)
#pragma unroll
            for (int i = 0; i < 4; ++i) { float ss = o[mt][i] * o[mt][i];
                ss += dpp_f<0x128>(ss); ss += dpp_f<0x124>(ss); ss += dpp_f<0x4E>(ss); ss += dpp_f<0xB1>(ss);
                if (fr == 0) atomicAdd(ROWT + 16 * mt + 4 * fq + i, ss); }
        unsigned rg[8];
#pragma unroll
        for (int mt = 0; mt < 4; ++mt)
#pragma unroll
            for (int i = 0; i < 4; i += 2) rg[mt * 2 + (i >> 1)] = (unsigned)RG[(16 * mt + 4 * fq + i) * 128 + 16 * w + fr] | ((unsigned)RG[(16 * mt + 4 * fq + i + 1) * 128 + 16 * w + fr] << 16);
        HG_BAR();
        f32x4 rt4[4];
#pragma unroll
        for (int mt = 0; mt < 4; ++mt) rt4[mt] = *(const f32x4*)(ROWT + 16 * mt + 4 * fq);
        int ocol = 16 * w + fr; asm volatile("" : "+v"(ocol)); const float gain = P.in[I_HGG][h * 128 + ocol];
        bf16_t* const orow = obase + (size_t)row0 * DM;
#pragma unroll
        for (int mt = 0; mt < 4; ++mt)
#pragma unroll
            for (int i = 0; i < 4; ++i) { const int t = 16 * mt + 4 * fq + i;
                const float r = rsqrtf(rt4[mt][i] * (1.f / 128.f) + RMS_EPS);
                const float g = (i & 1) ? bf2f(rg[mt * 2 + (i >> 1)] >> 16) : bf2f(rg[mt * 2 + (i >> 1)] & 0xffffu);
                orow[t * DM + ocol] = (bf16_t)f2bf(o[mt][i] * r * gain * (g * sigmoidf_(g))); }
      }
    }
    HG_BAR();
#undef HG_LOAD
#undef omlb
}

__device__ __forceinline__ void phase_attn(const Ctx& C, unsigned* ctr) {
    volatile unsigned* word = (volatile unsigned*)(C.lds + LDS_BYTES - 64);
    if (C.tid == 0) word[0] = atomicAdd(ctr, 1u);
    __syncthreads();
    unsigned cur = (unsigned)__builtin_amdgcn_readfirstlane((int)word[0]);
    for (int it = 0; cur < 4096u; ++it) {
        unsigned s_nx = 0u;
        if (C.wave == 0) { unsigned nx = 0u; if (C.lane == 0) nx = atomicAdd(ctr, 1u); s_nx = (unsigned)__builtin_amdgcn_readfirstlane((int)nx); }
        const int qb = 31 - (int)(cur >> 7), vhd = (int)(cur & 127u);
        const int b = vhd >> 4, h = (vhd >> 2) & 3, j = (vhd >> 1) & 1, vh = vhd & 1;
        const attn_body::bf16* Q = (const attn_body::bf16*)(C.PROJ + C_DQ + (h * 2 + j) * 64);
        const attn_body::bf16* K = (const attn_body::bf16*)(C.OARAW) + (size_t)(b * 8 + h * 2 + j) * SEQ * 64;
        const attn_body::bf16* V = (const attn_body::bf16*)(C.OARAW) + (size_t)32 * 1024 * 1024 + (size_t)(b * 4 + h) * SEQ * 128 + vh * 64;
        attn_body::bf16* O = (attn_body::bf16*)(C.OB4 + (h * 2 + j) * 128 + vh * 64);
        attn_body::attn_unit<8>(b, C.tid, qb, Q, K, V, O, (char*)C.lds);
        if (C.tid == 0) word[(it + 1) & 1] = s_nx;
        asm volatile("s_waitcnt lgkmcnt(0)" ::: "memory"); __builtin_amdgcn_s_barrier(); asm volatile("" ::: "memory");
        cur = (unsigned)__builtin_amdgcn_readfirstlane((int)word[(it + 1) & 1]);
    }
}

__device__ __forceinline__ void phase_branch_norm(const Params& P, const Ctx& C) {
    const int gw = C.vcu * 8 + C.wave, NGW = C.G * 8, l16 = C.lane & 15, rs = C.lane >> 4;
    const float* aux = C.MOD + 24576; const float lam = aux[0];
    for (int t4 = gw; t4 < NTOK / 4; t4 += NGW) {
        const size_t m = (size_t)t4 * 4 + rs;
#pragma unroll
        for (int h = 0; h < 4; ++h) {
            const f32x4 gn0 = *(const f32x4*)(aux + 64 + h * 128 + 8 * l16), gn1 = *(const f32x4*)(aux + 64 + h * 128 + 8 * l16 + 4);
            float o1[8], o2[8], g[8];
            unpack8(*(const u32x4*)(C.OB4 + m * DM + (h * 2 + 0) * 128 + 8 * l16), o1); unpack8(*(const u32x4*)(C.OB4 + m * DM + (h * 2 + 1) * 128 + 8 * l16), o2);
            unpack8(*(const u32x4*)(C.PROJ + m * NINP + C_DG + h * 128 + 8 * l16), g);
            float ss = 0.f;
#pragma unroll
            for (int i = 0; i < 8; ++i) { o1[i] -= lam * o2[i]; ss += o1[i] * o1[i]; }
            ss += swz_xor<1>(ss); ss += swz_xor<2>(ss); ss += swz_xor<4>(ss); ss += swz_xor<8>(ss);
            const float r = rsqrtf(ss * (1.f / 128.f) + RMS_EPS) * (1.0f - LAM_INIT);
            const float gv[8] = {gn0.x, gn0.y, gn0.z, gn0.w, gn1.x, gn1.y, gn1.z, gn1.w};
#pragma unroll
            for (int i = 0; i < 8; ++i) o1[i] = o1[i] * r * gv[i] * (g[i] * sigmoidf_(g[i]));
            u32x4 wv4; wv4.x = cvtpk(o1[0], o1[1]); wv4.y = cvtpk(o1[2], o1[3]); wv4.z = cvtpk(o1[4], o1[5]); wv4.w = cvtpk(o1[6], o1[7]);
            *(u32x4*)(C.OAB + m * DM + 512 + h * 128 + 8 * l16) = wv4; }
    }
}

__device__ __forceinline__ void phase_final(const Params& P, const Ctx& C) {
    const int gw = C.vcu * 8 + C.wave, NGW = C.G * 8;
    const float* gpo = P.in[I_GPOST];
    for (int m4 = gw; m4 < NTOK / 4; m4 += NGW) {
        const int m = m4 * 4, b = m >> 13;
        float rstd[4];
        { const f32x4* rp = (const f32x4*)(C.ROWSQ + (size_t)m * 16);
#pragma unroll
          for (int r = 0; r < 4; ++r) { const f32x4 a0 = rp[4 * r], a1 = rp[4 * r + 1], a2 = rp[4 * r + 2], a3 = rp[4 * r + 3]; const f32x4 sa = (a0 + a1) + (a2 + a3);
              rstd[r] = rsqrtf(((sa.x + sa.y) + (sa.z + sa.w)) * (1.f / DM) + RMS_EPS); } }
        const f32x4* xr = (const f32x4*)(P.in[I_X] + (size_t)m * DM) + C.lane; f32x4* zr = (f32x4*)(P.out + (size_t)m * DM) + C.lane;
        const bf16_t* zb = C.PROJ + 1024 + (size_t)m * NINP + C.lane * 4;
        f32x4 xv[16]; u32x2 zz[16];
#pragma unroll
        for (int j = 0; j < 16; ++j) { xv[j] = __builtin_nontemporal_load(xr + 64 * j); zz[j] = *(const u32x2*)(zb + (size_t)(j >> 2) * NINP + 256 * (j & 3)); }
#pragma unroll
        for (int j = 0; j < 4; ++j) { const int idx = (C.lane + 64 * j) * 4;
            const f32x4 g = *(const f32x4*)(gpo + idx), gt = *(const f32x4*)(C.MOD + b * 3072 + 2048 + idx); const f32x4 gg = g * gt;
#pragma unroll
            for (int r = 0; r < 4; ++r) { const u32x2 z = zz[4 * r + j]; const f32x4 zv = (f32x4){bf2f(z.x & 0xffffu), bf2f(z.x >> 16), bf2f(z.y & 0xffffu), bf2f(z.y >> 16)};
                __builtin_nontemporal_store(xv[4 * r + j] + gg * (zv * rstd[r]), zr + 256 * r + 64 * j); } }
    }
}


__device__ __forceinline__ void gsync(unsigned* bar, unsigned target, int tid) {
    asm volatile("s_waitcnt vmcnt(0)" ::: "memory");
    __syncthreads();
    if (tid == 0) {
        __builtin_amdgcn_fence(__ATOMIC_RELEASE, "agent"); asm volatile("s_waitcnt vmcnt(0)" ::: "memory");
        __hip_atomic_fetch_add(bar, 1u, __ATOMIC_RELAXED, __HIP_MEMORY_SCOPE_AGENT);
        while (__hip_atomic_load(bar, __ATOMIC_RELAXED, __HIP_MEMORY_SCOPE_AGENT) < target) __builtin_amdgcn_s_sleep(2);
        __builtin_amdgcn_fence(__ATOMIC_ACQUIRE, "agent"); asm volatile("s_waitcnt vmcnt(0)" ::: "memory");
    }
    __syncthreads();
}

#define LAS __attribute__((address_space(3)))
#define XB_TMO      128
#define XB_XCNT(j)  (256  + 64 * (j))
#define XB_XSUB(j)  (1280 + 64 * (j))
#define XB_XGEN(j)  (2304 + 64 * (j))
#define XB_TOP      3328
#define XB_TOPGEN   3392
#define XCD_BAR_WORDS 3456
#define XB_SPIN_CAP (1u << 18)

__device__ __forceinline__ unsigned xb_ld(unsigned* p)              { return __hip_atomic_load(p, __ATOMIC_RELAXED, __HIP_MEMORY_SCOPE_AGENT); }
__device__ __forceinline__ unsigned xb_add(unsigned* p, unsigned v) { return __hip_atomic_fetch_add(p, v, __ATOMIC_RELAXED, __HIP_MEMORY_SCOPE_AGENT); }
__device__ __forceinline__ unsigned xb_xcc_id() { return (unsigned)__builtin_amdgcn_s_getreg((3 << 11) | 20) & 0xFu; }
#define XB_SPIN(cond, bar) do { unsigned _sp = 0; while (cond) { __builtin_amdgcn_s_sleep(1); \
    if ((++_sp & 255u) == 0u) { if (xb_ld(&(bar)[XB_TMO])) break; if (_sp > XB_SPIN_CAP) { atomicAdd(&(bar)[XB_TMO], 1u); break; } } } } while (0)

struct XcdBarrier {
    unsigned* bar; unsigned x;
    volatile LAS unsigned* st;
};

__device__ __forceinline__ XcdBarrier xcd_barrier_post(unsigned* bar, volatile LAS unsigned* st, int tid) {
    XcdBarrier b; b.bar = bar; b.x = xb_xcc_id(); b.st = st;
    if (tid == 0) (void)xb_add(&bar[XB_XCNT(b.x)], 1u);
    return b;
}
__device__ __forceinline__ void xcd_barrier_complete(unsigned* bar, unsigned x, unsigned& nloc, unsigned& nx) {
    const unsigned G = gridDim.x * gridDim.y * gridDim.z;
    unsigned sum, cnt, mine, sp = 0u;
    for (;;) {
        sum = 0u; cnt = 0u; mine = 0u;
#pragma unroll
        for (unsigned j = 0; j < 16; ++j) { const unsigned c = xb_ld(&bar[XB_XCNT(j)]); sum += c; cnt += (c > 0u) ? 1u : 0u; mine = (j == x) ? c : mine; }
        if (sum == G) break;
        __builtin_amdgcn_s_sleep(1);
        if ((++sp & 255u) == 0u) { if (xb_ld(&bar[XB_TMO])) break; if (sp > XB_SPIN_CAP) { atomicAdd(&bar[XB_TMO], 1u); break; } }
    }
    nloc = mine > 0u ? mine : 1u; nx = cnt > 0u ? cnt : 1u;
}

__device__ __forceinline__ void xcd_barrier(const XcdBarrier& b, int tid) {
    asm volatile("s_waitcnt vmcnt(0)" ::: "memory");
    __syncthreads();
    if (tid == 0) {
        unsigned* bar = b.bar;
        __builtin_amdgcn_s_waitcnt(0);
        unsigned nloc = b.st[0], nx = b.st[1];
        if (nloc == 0u) { xcd_barrier_complete(bar, b.x, nloc, nx); b.st[0] = nloc; b.st[1] = nx; }
        const unsigned old = xb_add(&bar[XB_XSUB(b.x)], 1u);
        const unsigned gen = old / nloc;
        if (old + 1u == (gen + 1u) * nloc) {
            __builtin_amdgcn_fence(__ATOMIC_RELEASE, "agent");
            asm volatile("s_waitcnt vmcnt(0)" ::: "memory");
            const unsigned og = xb_add(&bar[XB_TOP], 1u);
            const unsigned tg = og / nx;
            if (og + 1u == (tg + 1u) * nx) xb_add(&bar[XB_TOPGEN], 1u);
            else XB_SPIN(xb_ld(&bar[XB_TOPGEN]) == tg, bar);
            __builtin_amdgcn_fence(__ATOMIC_ACQUIRE, "agent");
            xb_add(&bar[XB_XGEN(b.x)], 1u);
            asm volatile("s_waitcnt vmcnt(0)" ::: "memory");
        } else {
            XB_SPIN(xb_ld(&bar[XB_XGEN(b.x)]) == gen, bar);
            __builtin_amdgcn_fence(__ATOMIC_ACQUIRE, "agent");
            asm volatile("s_waitcnt vmcnt(0)" ::: "memory");
        }
    }
    __syncthreads();
}

__global__ void __launch_bounds__(NTHR, 2) fwd_kernel(Params P) {
    extern __shared__ __attribute__((aligned(16))) unsigned char lds[];
    cg::grid_group grid = cg::this_grid();
    Ctx C;
    C.lds = lds;
    C.G = gridDim.x; { const int bx = blockIdx.x; C.vcu = (C.G % 8 == 0) ? (bx % 8) * (C.G / 8) + bx / 8 : bx; }
    unsigned char* ws = P.ws;
    C.ROWSQ = (float*)(ws + WS_ROWSQ); C.MOD = (float*)(ws + WS_MOD);
    C.WIN = (bf16_t*)(ws + WS_WIN); C.WAB = (bf16_t*)(ws + WS_WAB); C.WOUT = (bf16_t*)(ws + WS_WOUT);
    C.XN = (bf16_t*)(ws + WS_XN); C.OAB = C.XN; C.PROJ = (bf16_t*)(ws + WS_PROJ);
    C.OARAW = P.out; C.OB4 = (bf16_t*)((unsigned char*)P.out + 128 * MiB);

    const int s_wave = __builtin_amdgcn_readfirstlane((int)threadIdx.x >> 6);
#define MY_TID() ({ int l_; asm volatile("v_mbcnt_lo_u32_b32 %0, -1, 0\n\tv_mbcnt_hi_u32_b32 %0, -1, %0" : "=v"(l_)); s_wave * 64 + l_; })
#define FRESH() do { int t_ = MY_TID(); asm volatile("" : "+v"(t_)); C.tid = t_; C.lane = t_ & 63; C.wave = s_wave; \
        unsigned char* w_ = P.ws; unsigned char* o_ = (unsigned char*)P.out; asm volatile("" : "+s"(w_), "+s"(o_));     \
        ws = w_; C.ROWSQ = (float*)(w_ + WS_ROWSQ); C.MOD = (float*)(w_ + WS_MOD); C.WIN = (bf16_t*)(w_ + WS_WIN); C.WAB = (bf16_t*)(w_ + WS_WAB); C.WOUT = (bf16_t*)(w_ + WS_WOUT); \
        C.XN = (bf16_t*)(w_ + WS_XN); C.OAB = C.XN; C.PROJ = (bf16_t*)(w_ + WS_PROJ); C.OARAW = (float*)o_; C.OB4 = (bf16_t*)(o_ + 128 * MiB); } while (0)
#ifdef PROBE_A
    unsigned long long* TS = (unsigned long long*)(ws + WS_QCTR + 1024);
#define STAMP(k) do { if (blockIdx.x == 0 && threadIdx.x == 0) TS[k] = __builtin_amdgcn_s_memrealtime(); } while (0)
#else
#define STAMP(k) do {} while (0)
#endif
    unsigned nbar = 0u;
#define GSYNC() xcd_barrier(xbar, C.tid)
    if (threadIdx.x < 2) ((volatile unsigned*)(lds + LDS_BYTES - 32))[threadIdx.x] = 0u;
    __syncthreads();
    FRESH();
    STAMP(0);
    if (blockIdx.x == 1) { for (int i = C.tid; i < 2048; i += NTHR) ((unsigned*)(ws + WS_QCTR))[i] = 0u; for (int i = C.tid; i < 3456; i += NTHR) ((unsigned*)(ws + WS_QCTR))[24576 + i] = 0u; }
    grid.sync(); FRESH();
    XcdBarrier xbar = xcd_barrier_post((unsigned*)(ws + WS_QCTR) + 24576, (volatile LAS unsigned*)((LAS unsigned char*)lds + LDS_BYTES - 32), C.tid);
    phase_prologue(P, C);
    GSYNC(); FRESH(); STAMP(1);
    phase_prenorm(P, C);
    GSYNC(); FRESH(); STAMP(2);
    { pg8::Gemm g{C.XN, C.WIN, NTOK, NIN, DM, DM, DM}; pg8::StaticOrder S; S.init(NTOK, NIN, C.G, (int)blockIdx.x); EpiProj2 E{C.PROJ, (bf16_t*)P.out, (bf16_t*)P.out + (size_t)32 * 1024 * 1024};
      pg8::gemm_phase<EpiProj2, pg8::StaticOrder, true, true>((PG8_LAS unsigned char*)lds, g, S, E, C.tid); }
    GSYNC(); FRESH(); STAMP(3);
    if (blockIdx.x < 32) hgrn_chain(P, C, (int)blockIdx.x >> 2, (int)blockIdx.x & 3);
    FRESH();
    phase_attn(C, (unsigned*)(ws + WS_QCTR));
    GSYNC(); FRESH(); STAMP(4);
    phase_branch_norm(P, C);
    GSYNC(); FRESH(); STAMP(5);
    { pg8::Gemm g{C.OAB, C.WAB, NTOK, DM, DM, DM, DM}; pg8::StaticOrder S; S.init(NTOK, DM, C.G, (int)blockIdx.x); EpiMerge2 E{C.PROJ, (bf16_t*)P.out};
      pg8::gemm_phase<EpiMerge2, pg8::StaticOrder, true, true>((PG8_LAS unsigned char*)lds, g, S, E, C.tid); }
    GSYNC(); FRESH(); STAMP(6);
    { pg8::Gemm g{(const bf16_t*)P.out, C.WOUT, NTOK, DM, DM, DM, DM}; pg8::StaticOrder S; S.init(NTOK, DM, C.G, (int)blockIdx.x); EpiZ2 E{C.PROJ + 1024, C.ROWSQ};
      pg8::gemm_phase<EpiZ2, pg8::StaticOrder, true, true>((PG8_LAS unsigned char*)lds, g, S, E, C.tid); }

    GSYNC(); FRESH();
    phase_final(P, C);
#ifdef PROBE_A
    { const float d2 = (float)(TS[PROBE_B + 1] - TS[PROBE_B]) * 1e-5f;
      for (int m = C.vcu * 8 + C.wave; m < NTOK; m += C.G * 8) { f32x4* zr = (f32x4*)(P.out + (size_t)m * DM) + C.lane;
          for (int j = 0; j < 4; ++j) zr[64 * j] = zr[64 * j] + d2; }
      GSYNC();
      if (blockIdx.x == 0 && threadIdx.x == 0) P.out[0] += (float)(TS[PROBE_A + 1] - TS[PROBE_A]) * 1e-4f; }
#endif
}

extern "C" void kernel_launch(void* const* d_in, const int* in_sizes, int n_in, void* d_out, int out_size, void* d_ws, size_t ws_size, hipStream_t stream) {
    static int grid = 0;
    if (grid == 0) {
        if (n_in != 17 || out_size != NTOK * DM || ws_size < WS_END) { fprintf(stderr, "kernel_launch: unexpected shapes (n_in %d out %d ws %zu)\n", n_in, out_size, ws_size); grid = -1; return; }
        int dev = 0, cus = 0, per_cu = 0;
        hipGetDevice(&dev); hipDeviceGetAttribute(&cus, hipDeviceAttributeMultiprocessorCount, dev);
        hipFuncSetAttribute((const void*)fwd_kernel, hipFuncAttributeMaxDynamicSharedMemorySize, LDS_BYTES);
        hipOccupancyMaxActiveBlocksPerMultiprocessor(&per_cu, (const void*)fwd_kernel, NTHR, LDS_BYTES);
        if (per_cu < 1) { fprintf(stderr, "kernel_launch: occupancy query says %d blocks per CU\n", per_cu); per_cu = 1; }
        grid = cus * 1; if (grid < 32) { fprintf(stderr, "kernel_launch: needs at least 32 CUs\n"); grid = -1; return; }
        (void)hipGetLastError();
    }
    if (grid < 0) return;
    Params p{};
    for (int i = 0; i < 17; ++i) p.in[i] = (const float*)d_in[i];
    p.out = (float*)d_out; p.ws = (unsigned char*)d_ws;
    void* args[] = {&p};
    hipError_t e = hipLaunchCooperativeKernel((const void*)fwd_kernel, dim3(grid), dim3(NTHR), args, LDS_BYTES, stream);
    if (e != hipSuccess) fprintf(stderr, "cooperative launch failed: %s (grid %d)\n", hipGetErrorString(e), grid);
}
```

```cpp
#include <hip/hip_runtime.h>
#include <hip/hip_cooperative_groups.h>
#include <cstdio>
#include <cstdint>
namespace cg = cooperative_groups;
namespace pg8 {
#define PG8_LAS __attribute__((address_space(3)))
typedef unsigned short bf16_t;
typedef short bf16x8 __attribute__((ext_vector_type(8)));
typedef float f32x4 __attribute__((ext_vector_type(4)));
typedef unsigned u32x4 __attribute__((ext_vector_type(4)));
constexpr int BM = 256, BK = 64, HALF = 128, HTB = HALF * BK * 2  , STAGE_BYTES = 8 * HTB, NXCD = 8, WGM = 8;

__host__ __device__ __forceinline__ int lds_byte(int r, int c) { const int st = (r >> 4) * 2 + (c >> 5), rr = r & 15, cc = c & 31, ob = rr * 64 + cc * 2; return st * 1024 + (ob ^ (((ob >> 9) & 1) << 5)); }
__host__ __device__ __forceinline__ void stage_rc(int b, int& R, int& C) { const int st = b / 1024, sb = b % 1024, swz = sb ^ (((sb >> 9) & 1) << 5); R = (st >> 1) * 16 + swz / 64; C = (st & 1) * 32 + (swz % 64) / 2; }
__host__ __device__ __forceinline__ int perm32(int rho) { const int n = rho >> 4, i = rho & 15; return 8 * (i >> 2) + 4 * n + (i & 3); }

struct Unit { int pm, pn; };
struct Gemm { const bf16_t* A; const bf16_t* Bt; int M, N, K, lda, ldb; };

struct StaticOrder {
    int nM, nN, nwg, G, c;
    __host__ __device__ void init(int M, int N, int G_, int c_) { nM = M / BM; nN = N / BM; nwg = nM * nN; G = G_; c = c_; }
    __host__ __device__ bool next(int i, Unit& u) const {
        const long L = (long)i * G + c; if (L >= nwg) return false;
        int wgid = (int)L; { const int q = nwg / NXCD, r = nwg % NXCD, xcd = wgid % NXCD, off = wgid / NXCD; wgid = (xcd < r ? xcd * (q + 1) : r * (q + 1) + (xcd - r) * q) + off; }
        const int nig = WGM * nN, gid = wgid / nig, fm = gid * WGM, gsz = (nM - fm) < WGM ? (nM - fm) : WGM;
        u.pm = fm + ((wgid % nig) % gsz); u.pn = (wgid % nig) / gsz; return true;
    }
    __device__ __forceinline__ void a_ready(const Unit&) const {}
    __device__ __forceinline__ void done(const Unit&) const {}
};

__device__ __forceinline__ unsigned cvt_pk_bf16(float lo, float hi) { unsigned r; asm volatile("v_cvt_pk_bf16_f32 %0, %1, %2" : "=v"(r) : "v"(lo), "v"(hi)); return r; }
typedef float f32x2 __attribute__((ext_vector_type(2)));
template <class Epi, class Sched, bool ALIGN_EPI = false, bool SP2 = false>
__device__ __forceinline__ void gemm_phase(PG8_LAS unsigned char* lds, const Gemm g, const Sched& S, const Epi& E, int tid_in) {
    int tid_ = tid_in; asm volatile("" : "+v"(tid_));
    const int tid = tid_, wid = __builtin_amdgcn_readfirstlane(tid >> 6), lane = tid & 63, wr = wid >> 2, wc = wid & 3, fr = lane & 15, fq = lane >> 4;
    const int K = g.K, nt = K / BK;
    unsigned voffA[2], voffB[2];
#pragma unroll
    for (int i = 0; i < 2; ++i) { int R, C; stage_rc(tid * 16 + i * 8192, R, C); const int Rb = Epi::PERM ? ((R & ~31) + perm32(R & 31)) : R;
        voffA[i] = (unsigned)(R * g.lda + C) * 2u; voffB[i] = (unsigned)(Rb * g.ldb + C) * 2u; }
    const size_t kstep = (size_t)(BK * 2);
    const size_t hstepA = (size_t)HALF * g.lda * 2, hstepB = (size_t)HALF * g.ldb * 2;
    const size_t tstepA = 2 * hstepA, tstepB = 2 * hstepB;
    const unsigned ldsw = (unsigned)wid * 1024u;
    const int aoff = lds_byte(wr * 64 + fr, fq * 8), boff = lds_byte(wc * 32 + fr, fq * 8);
#define PG8_SA(b, h) (((b) * 2 + (h)) * HTB)
#define PG8_SB(b, h) ((4 + (b) * 2 + (h)) * HTB)
#define PG8_STAGE(bufoff, gbase, voff) do { _Pragma("unroll") for (int _i = 0; _i < 2; ++_i) \
        __builtin_amdgcn_global_load_lds((const unsigned*)((const char*)(gbase) + (voff)[_i]), (PG8_LAS unsigned*)(lds + (bufoff) + ldsw + _i * 8192), 16, 0, 0); } while (0)
#define PG8_LDA(dst, b, h) do { _Pragma("unroll") for (int m = 0; m < 4; ++m) _Pragma("unroll") for (int k = 0; k < 2; ++k) dst[m][k] = *(const PG8_LAS bf16x8*)(lds + PG8_SA(b, h) + aoff + m * 2048 + k * 1024); } while (0)
#define PG8_LDB(dst, b, h) do { _Pragma("unroll") for (int n = 0; n < 2; ++n) _Pragma("unroll") for (int k = 0; k < 2; ++k) dst[n][k] = *(const PG8_LAS bf16x8*)(lds + PG8_SB(b, h) + boff + n * 2048 + k * 1024); } while (0)
#define PG8_MMA(ai, bj, At, Bt) do { __builtin_amdgcn_s_setprio(1); _Pragma("unroll") for (int m = 0; m < 4; ++m) _Pragma("unroll") for (int n = 0; n < 2; ++n) _Pragma("unroll") for (int k = 0; k < 2; ++k) \
        acc[ai][bj][m][n] = __builtin_amdgcn_mfma_f32_16x16x32_bf16(Bt[n][k], At[m][k], acc[ai][bj][m][n], 0, 0, 0); __builtin_amdgcn_s_setprio(0); } while (0)
#define PG8_WAIT_V(n) asm volatile("s_waitcnt vmcnt(" #n ")" ::: "memory")
#define PG8_WAIT_L(n) asm volatile("s_waitcnt lgkmcnt(" #n ")" ::: "memory")
#define PG8_BAR __builtin_amdgcn_s_barrier()
#define PG8_SCHED __builtin_amdgcn_sched_barrier(0)
    Unit cur, nxt; int ui = 0;
    if (!S.next(0, cur)) return;
    f32x4 acc[2][2][4][2];
#pragma unroll
    for (int a = 0; a < 2; ++a)
#pragma unroll
        for (int b = 0; b < 2; ++b)
#pragma unroll
            for (int m = 0; m < 4; ++m)
#pragma unroll
                for (int n = 0; n < 2; ++n) acc[a][b][m][n] = (f32x4){0.f, 0.f, 0.f, 0.f};
    bf16x8 At[4][2], B0[2][2], B1[2][2];
    const char* cA = (const char*)g.A + (size_t)cur.pm * tstepA; const char* cB = (const char*)g.Bt + (size_t)cur.pn * tstepB;
    S.a_ready(cur);
    if constexpr (SP2) {
        PG8_STAGE(PG8_SB(0, 0), cB, voffB); PG8_STAGE(PG8_SB(0, 1), cB + hstepB, voffB); PG8_STAGE(PG8_SA(0, 0), cA, voffA); PG8_STAGE(PG8_SA(0, 1), cA + hstepA, voffA);
        if (wr == 1) PG8_BAR;
        PG8_WAIT_V(2); PG8_BAR;
        PG8_STAGE(PG8_SB(1, 0), cB + kstep, voffB); PG8_STAGE(PG8_SA(1, 0), cA + kstep, voffA); PG8_STAGE(PG8_SB(1, 1), cB + hstepB + kstep, voffB);
        PG8_WAIT_V(6); PG8_BAR;
    } else {
        PG8_STAGE(PG8_SB(0, 0), cB, voffB); PG8_STAGE(PG8_SA(0, 0), cA, voffA); PG8_STAGE(PG8_SB(0, 1), cB + hstepB, voffB); PG8_STAGE(PG8_SA(0, 1), cA + hstepA, voffA);
        if (wr == 1) PG8_BAR;
        PG8_WAIT_V(4); PG8_BAR;
        PG8_STAGE(PG8_SB(1, 0), cB + kstep, voffB); PG8_STAGE(PG8_SA(1, 0), cA + kstep, voffA); PG8_STAGE(PG8_SB(1, 1), cB + hstepB + kstep, voffB);
        PG8_WAIT_V(6); PG8_BAR;
    }
    for (;;) {
        const bool has_next = S.next(ui + 1, nxt);
        const char* nA = has_next ? (const char*)g.A + (size_t)nxt.pm * tstepA : cA; const char* nB = has_next ? (const char*)g.Bt + (size_t)nxt.pn * tstepB : cB;
        for (int t = 0; t < nt; t += 2) {
            const bool last = (t == nt - 2);
            const char* a1 = cA + (size_t)(t + 1) * kstep;
            const char* a2 = last ? nA : cA + (size_t)(t + 2) * kstep; const char* b2 = last ? nB : cB + (size_t)(t + 2) * kstep;
            const char* a3 = a2 + kstep; const char* b3 = b2 + kstep;
            if (last && has_next) S.a_ready(nxt);
            if constexpr (Epi::MID) { if (t == nt / 2) E.mid(acc, cur, wr, wc, fr, fq); }
            if constexpr (SP2) {
            PG8_LDB(B0, 0, 0); PG8_LDB(B1, 0, 1); PG8_SCHED; PG8_LDA(At, 0, 0); PG8_STAGE(PG8_SA(1, 1), a1 + hstepA, voffA);
            PG8_WAIT_V(8); PG8_WAIT_L(0); PG8_BAR; PG8_MMA(0, 0, At, B0); PG8_MMA(0, 1, At, B1); PG8_BAR; PG8_SCHED;
            PG8_LDA(At, 0, 1); PG8_STAGE(PG8_SB(0, 0), b2, voffB); PG8_STAGE(PG8_SB(0, 1), b2 + hstepB, voffB); PG8_STAGE(PG8_SA(0, 0), a2, voffA);
            PG8_WAIT_V(8); PG8_WAIT_L(0); PG8_BAR; PG8_MMA(1, 0, At, B0); PG8_MMA(1, 1, At, B1); PG8_BAR; PG8_SCHED;
            PG8_LDB(B0, 1, 0); PG8_LDB(B1, 1, 1); PG8_SCHED; PG8_LDA(At, 1, 0); PG8_STAGE(PG8_SA(0, 1), a2 + hstepA, voffA);
            PG8_WAIT_V(8); PG8_WAIT_L(0); PG8_BAR; PG8_MMA(0, 0, At, B0); PG8_MMA(0, 1, At, B1); PG8_BAR; PG8_SCHED;
            PG8_LDA(At, 1, 1); PG8_STAGE(PG8_SB(1, 0), b3, voffB); PG8_STAGE(PG8_SB(1, 1), b3 + hstepB, voffB); PG8_STAGE(PG8_SA(1, 0), a3, voffA);
            PG8_WAIT_V(8); PG8_WAIT_L(0); PG8_BAR; PG8_MMA(1, 0, At, B0); PG8_MMA(1, 1, At, B1); PG8_BAR; PG8_SCHED;
            } else {
            PG8_LDB(B0, 0, 0); PG8_SCHED; PG8_LDA(At, 0, 0); PG8_STAGE(PG8_SA(1, 1), a1 + hstepA, voffA);
            PG8_WAIT_L(8); PG8_BAR; PG8_WAIT_L(0); PG8_MMA(0, 0, At, B0); PG8_BAR; PG8_SCHED;
            PG8_LDB(B1, 0, 1); PG8_STAGE(PG8_SB(0, 0), b2, voffB);
            PG8_BAR; PG8_WAIT_L(0); PG8_MMA(0, 1, At, B1); PG8_BAR;
            PG8_LDA(At, 0, 1); PG8_STAGE(PG8_SA(0, 0), a2, voffA);
            PG8_BAR; PG8_WAIT_L(0); PG8_MMA(1, 0, At, B0); PG8_BAR; PG8_SCHED;
            PG8_STAGE(PG8_SB(0, 1), b2 + hstepB, voffB);
            PG8_WAIT_V(6); PG8_BAR; PG8_MMA(1, 1, At, B1); PG8_BAR;
            PG8_LDB(B0, 1, 0); PG8_SCHED; PG8_LDA(At, 1, 0); PG8_STAGE(PG8_SA(0, 1), a2 + hstepA, voffA);
            PG8_WAIT_L(8); PG8_BAR; PG8_WAIT_L(0); PG8_MMA(0, 0, At, B0); PG8_BAR; PG8_SCHED;
            PG8_LDB(B1, 1, 1); PG8_STAGE(PG8_SB(1, 0), b3, voffB);
            PG8_BAR; PG8_WAIT_L(0); PG8_MMA(0, 1, At, B1); PG8_BAR;
            PG8_LDA(At, 1, 1); PG8_STAGE(PG8_SA(1, 0), a3, voffA);
            PG8_BAR; PG8_WAIT_L(0); PG8_MMA(1, 0, At, B0); PG8_BAR; PG8_SCHED;
            PG8_STAGE(PG8_SB(1, 1), b3 + hstepB, voffB);
            PG8_WAIT_V(6); PG8_BAR; PG8_MMA(1, 1, At, B1); PG8_BAR;
            }
        }
        if constexpr (ALIGN_EPI) { if (wr == 0) PG8_BAR; }
        if constexpr (!Epi::AFTER_DRAIN) { E(acc, cur, wr, wc, fr, fq); S.done(cur); }
        if constexpr (Epi::POST) { static_assert(ALIGN_EPI, "post hook: both half-workgroups must be barrier-aligned here"); E.post(cur, lds, tid); }
        if (!has_next) break;
#pragma unroll
        for (int a = 0; a < 2; ++a)
#pragma unroll
            for (int b = 0; b < 2; ++b)
#pragma unroll
                for (int m = 0; m < 4; ++m)
#pragma unroll
                    for (int n = 0; n < 2; ++n) acc[a][b][m][n] = (f32x4){0.f, 0.f, 0.f, 0.f};
        cur = nxt; cA = nA; cB = nB; ++ui;
        if constexpr (ALIGN_EPI) { if (wr == 1) PG8_BAR; }
    }
    PG8_WAIT_V(0);
    if constexpr (!ALIGN_EPI) { if (wr == 0) PG8_BAR; }
    PG8_BAR;
    if constexpr (Epi::AFTER_DRAIN) { E.fused(acc, cur, wr, wc, fr, fq, lds, wid, lane); S.done(cur); }
#undef PG8_SA
#undef PG8_SB
#undef PG8_STAGE
#undef PG8_LDA
#undef PG8_LDB
#undef PG8_MMA
#undef PG8_WAIT_V
#undef PG8_WAIT_L
#undef PG8_BAR
#undef PG8_SCHED
}
}
#include <hip/hip_bf16.h>
#include <cmath>
namespace attn_body {
using bf16=__hip_bfloat16;
using bf16x8=__attribute__((ext_vector_type(8)))short;
using s16x4=__attribute__((ext_vector_type(4)))short;
using f32x16=__attribute__((ext_vector_type(16)))float;
using u32x4=__attribute__((ext_vector_type(4)))unsigned;
constexpr int SEQ=8192,D=64,PIN=6272,PO=1024,PK=64,PV=128;
constexpr int NW=8,QBLK=32,QB=QBLK*NW,KVBLK=64,NQB=SEQ/QB;
constexpr int ATTN_UNIT_ROWS=QB;
__device__ __forceinline__ int crow(int r,int hi){return (r&3)+8*(r>>2)+4*hi;}
#define SBAR() __builtin_amdgcn_sched_barrier(0)
__device__ __forceinline__ void cmask(f32x16&p0,f32x16&p1,int jb,int qrel,int hi){
  const float NEG=-INFINITY; int kb=64*jb+4*hi;
  #pragma unroll
  for(int r=0;r<16;++r){int kv=kb+(r&3)+8*(r>>2); if(kv>qrel)p0[r]=NEG; if(kv+32>qrel)p1[r]=NEG;}
}

constexpr int NSLOT=3, SLOTB=8192;
constexpr int LDS_K=0, LDS_V=NSLOT*SLOTB, LDS_WS=2*NSLOT*SLOTB, LDS_OST=LDS_WS+NW*64*4, LDS_BYTES=LDS_OST+NW*4096;
constexpr float C2=0.125f*1.4426950408889634f;
__device__ __forceinline__ void glds16(const void*gsrc,unsigned lds_dst){unsigned keep;
  asm volatile("s_mov_b32 %0, m0\n\ts_mov_b32 m0, %2\n\ts_nop 0\n\tglobal_load_lds_dwordx4 %1, off\n\ts_mov_b32 m0, %0":"=&s"(keep):"v"(gsrc),"s"(lds_dst):"memory");}
__device__ __forceinline__ float max3f(float a,float b,float c){float r;asm("v_max3_f32 %0, %1, %2, %3":"=v"(r):"v"(a),"v"(b),"v"(c));return r;}
__device__ __forceinline__ float max2f(float a,float b){float r;asm("v_max_f32_e32 %0, %1, %2":"=v"(r):"v"(a),"v"(b));return r;}
__device__ __forceinline__ float fadd_s(float a,float b){float r;asm("v_add_f32_e32 %0, %1, %2":"=v"(r):"v"(a),"v"(b));return r;}
__device__ __forceinline__ float fsub_s(float a,float b){float r;asm("v_sub_f32_e32 %0, %1, %2":"=v"(r):"v"(a),"v"(b));return r;}
typedef float f32x2_t __attribute__((ext_vector_type(2))); typedef __bf16 bf16x2_t __attribute__((ext_vector_type(2)));
__device__ __forceinline__ unsigned cvtpk_s(float lo,float hi){f32x2_t v={lo,hi};bf16x2_t b=__builtin_convertvector(v,bf16x2_t);return __builtin_bit_cast(unsigned,b);}
#define WAIT_BAR(N) asm volatile("s_waitcnt vmcnt(" #N ") lgkmcnt(0)\n\ts_barrier":::"memory")

__device__ __forceinline__ void qkt(f32x16&p0,f32x16&p1,const char*Kslot,const bf16x8*qr,const f32x16&negm,int r32,int hi){
  const char*kb=Kslot+hi*1024+r32*16;
  #pragma unroll
  for(int d0=0;d0<4;++d0){
    const bf16x8 b0=*reinterpret_cast<const bf16x8*>(kb+d0*2048);
    const bf16x8 b1=*reinterpret_cast<const bf16x8*>(kb+d0*2048+512);
    if(d0==0){p0=__builtin_amdgcn_mfma_f32_32x32x16_bf16(b0,qr[0],negm,0,0,0);p1=__builtin_amdgcn_mfma_f32_32x32x16_bf16(b1,qr[0],negm,0,0,0);}
    else{p0=__builtin_amdgcn_mfma_f32_32x32x16_bf16(b0,qr[d0],p0,0,0,0);p1=__builtin_amdgcn_mfma_f32_32x32x16_bf16(b1,qr[d0],p1,0,0,0);}}
}
typedef __attribute__((address_space(3))) const char* lds_cptr;
typedef short v4i16_t __attribute__((ext_vector_type(4)));
__device__ __forceinline__ void kload8(bf16x8*kf,lds_cptr kp){
  kf[0]=*(const __attribute__((address_space(3))) bf16x8*)(kp);      kf[1]=*(const __attribute__((address_space(3))) bf16x8*)(kp+512);
  kf[2]=*(const __attribute__((address_space(3))) bf16x8*)(kp+2048); kf[3]=*(const __attribute__((address_space(3))) bf16x8*)(kp+2560);
  kf[4]=*(const __attribute__((address_space(3))) bf16x8*)(kp+4096); kf[5]=*(const __attribute__((address_space(3))) bf16x8*)(kp+4608);
  kf[6]=*(const __attribute__((address_space(3))) bf16x8*)(kp+6144); kf[7]=*(const __attribute__((address_space(3))) bf16x8*)(kp+6656);
}
__device__ __forceinline__ void kload2(bf16x8*kf,lds_cptr kp,int j){ kf[2*j]=*(const __attribute__((address_space(3))) bf16x8*)(kp+j*2048); kf[2*j+1]=*(const __attribute__((address_space(3))) bf16x8*)(kp+j*2048+512); }
__device__ __forceinline__ s16x4 vtr(lds_cptr p){ return __builtin_bit_cast(s16x4,__builtin_amdgcn_ds_read_tr16_b64_v4i16((__attribute__((address_space(3))) v4i16_t*)p)); }
__device__ __forceinline__ float rowmax(const f32x16&p0,const f32x16&p1){
  float a=max3f(p0[0],p0[1],p1[0]),b=max3f(p0[2],p0[3],p1[1]);a=max3f(a,p1[2],p1[3]);
  #pragma unroll
  for(int r=4;r<16;r+=4){a=max3f(a,p0[r],p0[r+1]);b=max3f(b,p0[r+2],p0[r+3]);a=max3f(a,p1[r],p1[r+1]);b=max3f(b,p1[r+2],p1[r+3]);}
  const float m=max2f(a,b);
  auto rr=__builtin_amdgcn_permlane32_swap(__float_as_uint(m),__float_as_uint(m),false,false);
  return max2f(__uint_as_float(rr[0]),__uint_as_float(rr[1]));
}
__device__ __forceinline__ void pv(f32x16*o,int vb,bf16x8 pa0,bf16x8 pa1,bf16x8 pa2,bf16x8 pa3){
  #pragma unroll
  for(int d0=0;d0<2;++d0){s16x4 lo[4],hi[4];
    #pragma unroll
    for(int ks=0;ks<4;++ks){
      asm volatile("ds_read_b64_tr_b16 %0,%1 offset:%c2":"=&v"(lo[ks]):"v"(vb),"i"(d0*4096+ks*1024):"memory");
      asm volatile("ds_read_b64_tr_b16 %0,%1 offset:%c2":"=&v"(hi[ks]):"v"(vb),"i"(d0*4096+ks*1024+512):"memory");}
    asm volatile("s_waitcnt lgkmcnt(0)":::"memory");SBAR();
    #define PK(k) (bf16x8){lo[k][0],lo[k][1],lo[k][2],lo[k][3],hi[k][0],hi[k][1],hi[k][2],hi[k][3]}
    o[d0]=__builtin_amdgcn_mfma_f32_32x32x16_bf16(pa0,PK(0),o[d0],0,0,0);
    o[d0]=__builtin_amdgcn_mfma_f32_32x32x16_bf16(pa1,PK(1),o[d0],0,0,0);
    o[d0]=__builtin_amdgcn_mfma_f32_32x32x16_bf16(pa2,PK(2),o[d0],0,0,0);
    o[d0]=__builtin_amdgcn_mfma_f32_32x32x16_bf16(pa3,PK(3),o[d0],0,0,0);
    #undef PK
  }
}

#ifndef ATTN_STORE16
#define ATTN_STORE16(p,v) __builtin_nontemporal_store((v),(u32x4*)(p))
#endif
template<int THRL> __device__ __forceinline__ void attn_unit(int b,int h,int qb,const bf16*Q,const bf16*__restrict__ K,const bf16*__restrict__ V,bf16*O,char*shm){
  const int tid=h,lane=tid&63,r32=lane&31,hi=lane>>5;     const int wid=__builtin_amdgcn_readfirstlane(tid>>6);
  const long rowbase=(long)b*SEQ; const int q0=qb*QB;
  const bf16*Qw=Q+(rowbase+q0+wid*QBLK)*PIN;
  const bf16*Kh=K,*Vh=V;
  const unsigned lds0=(unsigned)(uintptr_t)shm;
  float*wsf=(float*)(shm+LDS_WS)+wid*64;
  const bf16*ksrc=Kh+(long)lane*PK+wid*8;
  const bf16*vsrc=Vh+(long)(16*(wid&3)+(lane>>2))*PV+(wid>>2)*32+(lane&3)*8;
  const unsigned kdst=lds0+LDS_K+wid*1024, vdst=lds0+LDS_V+wid*1024;
  #define DMA_K(t,slot) glds16(ksrc+(long)(t)*KVBLK*PK,(unsigned)__builtin_amdgcn_readfirstlane(kdst+(slot)))
  #define DMA_V(t,slot) glds16(vsrc+(long)(t)*KVBLK*PV,(unsigned)__builtin_amdgcn_readfirstlane(vdst+(slot)))
  const int vb0=(int)(lds0+LDS_V)+((lane>>4)&1)*32+(lane&3)*8+(4*hi+((lane&15)>>2))*64;
  const char*Kbase=shm+LDS_K; bf16x8 kf[8];
  const lds_cptr shm3=(lds_cptr)shm; const lds_cptr kp0=shm3+LDS_K+hi*1024+r32*16; const lds_cptr vp0=shm3+LDS_V+((lane>>4)&1)*32+(lane&3)*8+(4*hi+((lane&15)>>2))*64;
  const int NT=(q0+QB)/KVBLK;
  DMA_K(0,0);DMA_V(0,0);DMA_K(1,SLOTB);
  bf16x8 qr[4];
  #pragma unroll
  for(int d0=0;d0<4;++d0)qr[d0]=*reinterpret_cast<const bf16x8*>(&Qw[(long)r32*PIN+d0*16+hi*8]);
  float mhat=0.f,l_reg=0.f;float zz_;asm volatile("v_mov_b32 %0, 0":"=v"(zz_));f32x16 o[2];_Pragma("unroll") for(int r=0;r<16;++r){o[0][r]=zz_;o[1][r]=zz_;}f32x16 negm;_Pragma("unroll") for(int r=0;r<16;++r)negm[r]=zz_;asm volatile("":"+v"(negm));
  const int qrel=wid*QBLK+r32;
  #define CMASK(P0,P1,t) do{int jb_=(t)-(NT-4); if(jb_>=0)cmask(P0,P1,jb_,qrel,hi);}while(0)
  bool resc=false;
  #define START(P0,P1) do{ const float rm=rowmax(P0,P1); resc=false; \
    { const float dl=rm; mhat=fadd_s(mhat,dl); \
      _Pragma("unroll") for(int r=0;r<16;++r){P0[r]=fsub_s(P0[r],dl);P1[r]=fsub_s(P1[r],dl);} \
      _Pragma("unroll") for(int r=0;r<16;++r)negm[r]=-mhat; asm volatile("":"+v"(negm)); } \
    _Pragma("unroll") for(int r=0;r<16;++r)P0[r]=__builtin_amdgcn_exp2f(P0[r]); }while(0)
  #define RESC() do{ if(resc){ asm volatile("s_waitcnt lgkmcnt(0)":::"memory"); \
      _Pragma("unroll") for(int d_=0;d_<2;++d_) _Pragma("unroll") for(int r=0;r<16;++r)o[d_][r]*=wsf[crow(r,hi)]; } }while(0)
  f32x16 pA0,pA1,pB0,pB1;
  int sl_prev=0,sl_cur=0,sl_next=SLOTB;
  #define ROT() do{sl_prev=sl_cur;sl_cur=sl_next;sl_next=(sl_next==(NSLOT-1)*SLOTB)?0:sl_next+SLOTB;}while(0)
  DMA_K(2,2*SLOTB);
  WAIT_BAR(3);
  qkt(pA0,pA1,Kbase,qr,negm,r32,hi);asm volatile("s_nop 15\n\ts_nop 7":"+v"(pA0),"+v"(pA1));CMASK(pA0,pA1,0);
  START(pA0,pA1);
  _Pragma("unroll") for(int r=0;r<16;++r)pA1[r]=__builtin_amdgcn_exp2f(pA1[r]);
  WAIT_BAR(0);
  DMA_K(3,0);DMA_V(1,SLOTB);
  ROT();
  kload8(kf,kp0+sl_cur);
  WAIT_BAR(2);
  s16x4 vlo[8],vhi[8]; u32x4 pw0,pw1,pw2,pw3;
  #define PKW(P,B) cvtpk_s(P[B],P[B+1])
  #define PAF(k) __builtin_bit_cast(bf16x8,pw##k)
  #define VFR(i) (bf16x8){vlo[i][0],vlo[i][1],vlo[i][2],vlo[i][3],vhi[i][0],vhi[i][1],vhi[i][2],vhi[i][3]}
  #define PIN(x) asm volatile("":"+v"(x))
  #define MX3(a,b,c) __builtin_fmaxf(__builtin_fmaxf((a),(b)),(c))
  #define GAPA(MF,A0,A1,A2,A3,W0,W1,PW) do{ MF; sacc+=A0; sacc+=A1; sacc+=A2; sacc+=A3; PIN(sacc); W0; W1; PIN(PW); SBAR(); }while(0)
  #define EX(v) __builtin_amdgcn_exp2f(v)
  #define GAPB(MF,X,B) do{ MF; X[B]=EX(X[B]); X[B+1]=EX(X[B+1]); X[B+2]=EX(X[B+2]); X[B+3]=EX(X[B+3]); PIN(X); SBAR(); }while(0)
  #define VRD(i) do{ vlo[i]=vtr(vp_+(((i)>>2)*4096+((i)&3)*1024)); vhi[i]=vtr(vp_+(((i)>>2)*4096+((i)&3)*1024+512)); }while(0)
  #define KRD(G,j) do{ if(G){ kload2(kf,kp0+sl_next,j); SBAR(); } }while(0)
  #define STEP(C0,C1,P0,P1,t,GK,GV,GL) do{ SBAR(); \
    const lds_cptr vp_=vp0+sl_prev; \
    VRD(0); SBAR(); float sacc=(P0[0]+P0[1]); \
    GAPA(C0=__builtin_amdgcn_mfma_f32_32x32x16_bf16(kf[0],qr[0],negm,0,0,0), P0[2],P0[3],P0[4],P0[5],     pw0[0]=PKW(P0,0), pw0[1]=PKW(P0,2), pw0); \
    VRD(4); SBAR(); GAPA(C1=__builtin_amdgcn_mfma_f32_32x32x16_bf16(kf[1],qr[0],negm,0,0,0), P0[6],P0[7],P0[8],P0[9],     pw0[2]=PKW(P0,4), pw0[3]=PKW(P0,6), pw0); \
    VRD(1); SBAR(); GAPA(C0=__builtin_amdgcn_mfma_f32_32x32x16_bf16(kf[2],qr[1],C0,0,0,0),   P0[10],P0[11],P0[12],P0[13], pw1[0]=PKW(P0,8), pw1[1]=PKW(P0,10), pw1); \
    VRD(5); SBAR(); GAPA(C1=__builtin_amdgcn_mfma_f32_32x32x16_bf16(kf[3],qr[1],C1,0,0,0),   P0[14],P0[15],P1[0],P1[1],   pw1[2]=PKW(P0,12),pw1[3]=PKW(P0,14), pw1); \
    VRD(2); SBAR(); GAPA(C0=__builtin_amdgcn_mfma_f32_32x32x16_bf16(kf[4],qr[2],C0,0,0,0),   P1[2],P1[3],P1[4],P1[5],     pw2[0]=PKW(P1,0), pw2[1]=PKW(P1,2), pw2); \
    VRD(6); SBAR(); GAPA(C1=__builtin_amdgcn_mfma_f32_32x32x16_bf16(kf[5],qr[2],C1,0,0,0),   P1[6],P1[7],P1[8],P1[9],     pw2[2]=PKW(P1,4), pw2[3]=PKW(P1,6), pw2); \
    VRD(3); SBAR(); GAPA(C0=__builtin_amdgcn_mfma_f32_32x32x16_bf16(kf[6],qr[3],C0,0,0,0),   P1[10],P1[11],P1[12],P1[13], pw3[0]=PKW(P1,8), pw3[1]=PKW(P1,10), pw3); \
    VRD(7); SBAR(); GAPA(C1=__builtin_amdgcn_mfma_f32_32x32x16_bf16(kf[7],qr[3],C1,0,0,0),   P1[14],P1[15],0.f,0.f,       pw3[2]=PKW(P1,12),pw3[3]=PKW(P1,14), pw3); \
    l_reg+=sacc; \
    if(GK){DMA_K((t)+3,sl_cur);} if(GV){DMA_V((t)+1,sl_next);} \
    CMASK(C0,C1,t); \
    { float a=MX3(C0[0],C0[1],C1[0]),b=MX3(C0[2],C0[3],C1[1]); a=MX3(a,C1[2],C1[3]); \
      _Pragma("unroll") for(int r=4;r<16;r+=4){a=MX3(a,C0[r],C0[r+1]);b=MX3(b,C0[r+2],C0[r+3]);a=MX3(a,C1[r],C1[r+1]);b=MX3(b,C1[r+2],C1[r+3]);} \
      float rm=__builtin_fmaxf(a,b); { auto rr=__builtin_amdgcn_permlane32_swap(__float_as_uint(rm),__float_as_uint(rm),false,false); rm=__builtin_fmaxf(__uint_as_float(rr[0]),__uint_as_float(rr[1])); } \
      resc=false; \
      if(__builtin_expect(__any(rm>(float)THRL),0)){ const float dl=__builtin_fmaxf(rm,0.f); mhat+=dl; \
        _Pragma("unroll") for(int r=0;r<16;++r){C0[r]-=dl;C1[r]-=dl;} \
        _Pragma("unroll") for(int r=0;r<16;++r)negm[r]=-mhat; asm volatile("":"+v"(negm)); \
        const float f=__builtin_amdgcn_exp2f(-dl); l_reg*=f; if(hi==0)wsf[r32]=f; resc=true; } } \
    SBAR(); \
    GAPB(o[0]=__builtin_amdgcn_mfma_f32_32x32x16_bf16(PAF(0),VFR(0),o[0],0,0,0), C0,0); \
    GAPB(o[1]=__builtin_amdgcn_mfma_f32_32x32x16_bf16(PAF(0),VFR(4),o[1],0,0,0), C0,4); \
    KRD(GL,0); GAPB(o[0]=__builtin_amdgcn_mfma_f32_32x32x16_bf16(PAF(1),VFR(1),o[0],0,0,0), C0,8); \
    KRD(GL,1); GAPB(o[1]=__builtin_amdgcn_mfma_f32_32x32x16_bf16(PAF(1),VFR(5),o[1],0,0,0), C0,12); \
    KRD(GL,2); GAPB(o[0]=__builtin_amdgcn_mfma_f32_32x32x16_bf16(PAF(2),VFR(2),o[0],0,0,0), C1,0); \
    KRD(GL,3); GAPB(o[1]=__builtin_amdgcn_mfma_f32_32x32x16_bf16(PAF(2),VFR(6),o[1],0,0,0), C1,4); \
    GAPB(o[0]=__builtin_amdgcn_mfma_f32_32x32x16_bf16(PAF(3),VFR(3),o[0],0,0,0), C1,8); \
    GAPB(o[1]=__builtin_amdgcn_mfma_f32_32x32x16_bf16(PAF(3),VFR(7),o[1],0,0,0), C1,12); \
    }while(0)
  int t=1;
  #undef CMASK
  #define CMASK(P0,P1,t) do{}while(0)
  for(;t+5<NT;t+=2){
    STEP(pB0,pB1,pA0,pA1,t,true,true,true);     WAIT_BAR(2); RESC(); ROT();
    STEP(pA0,pA1,pB0,pB1,t+1,true,true,true);   WAIT_BAR(2); RESC(); ROT();
  }
  #undef CMASK
  #define CMASK(P0,P1,t) do{int jb_=(t)-(NT-4); if(jb_>=0)cmask(P0,P1,jb_,qrel,hi);}while(0)
  #define ENDW(tt) do{ if((tt)+3<NT){WAIT_BAR(2);} else if((tt)+2<NT){WAIT_BAR(1);} else {WAIT_BAR(0);} }while(0)
  for(;t+1<NT;t+=2){
    STEP(pB0,pB1,pA0,pA1,t,(t+3<NT),(t+1<NT),(t+1<NT));       ENDW(t);   RESC(); ROT();
    STEP(pA0,pA1,pB0,pB1,t+1,(t+4<NT),(t+2<NT),(t+2<NT));     ENDW(t+1); RESC(); ROT();
  }
  STEP(pB0,pB1,pA0,pA1,NT-1,false,false,false); RESC();
  { float sacc=pB0[0]+pB0[1]; _Pragma("unroll") for(int r=2;r<16;++r)sacc+=pB0[r]; _Pragma("unroll") for(int r=0;r<16;++r)sacc+=pB1[r]; l_reg+=sacc;
    pw0=(u32x4){PKW(pB0,0),PKW(pB0,2),PKW(pB0,4),PKW(pB0,6)};pw1=(u32x4){PKW(pB0,8),PKW(pB0,10),PKW(pB0,12),PKW(pB0,14)};pw2=(u32x4){PKW(pB1,0),PKW(pB1,2),PKW(pB1,4),PKW(pB1,6)};pw3=(u32x4){PKW(pB1,8),PKW(pB1,10),PKW(pB1,12),PKW(pB1,14)};
    SBAR(); pv(o,vb0+sl_cur,PAF(0),PAF(1),PAF(2),PAF(3)); }
  #undef PKW
  #undef PAF
  #undef VFR
  #undef PIN
  #undef MX3
  #undef GAPA
  #undef GAPB
  #undef EX
  #undef VRD
  #undef KRD
  #undef STEP
  #undef ENDW
  {auto rr=__builtin_amdgcn_permlane32_swap(__float_as_uint(l_reg),__float_as_uint(l_reg),false,false);l_reg=__uint_as_float(rr[0])+__uint_as_float(rr[1]);}
  if(hi==0)wsf[32+r32]=l_reg;asm volatile("s_waitcnt lgkmcnt(0)":::"memory");
  float rli[16];
  #pragma unroll
  for(int r=0;r<16;++r)rli[r]=__builtin_amdgcn_rcpf(wsf[32+crow(r,hi)]);
  bf16*Ow=O+(rowbase+q0+wid*QBLK)*PO;
  { bf16*stg=(bf16*)(shm+LDS_OST)+wid*2048;
    #pragma unroll
    for(int r=0;r<16;++r){const int orow=crow(r,hi);
      #pragma unroll
      for(int d0=0;d0<2;++d0)stg[orow*64+d0*32+r32]=__float2bfloat16(o[d0][r]*rli[r]);}
    asm volatile("s_waitcnt lgkmcnt(0)":::"memory");
    #pragma unroll
    for(int i=0;i<4;++i){const int row=i*8+(lane>>3),ch=lane&7; const u32x4 v=*(const u32x4*)(stg+row*64+ch*8); ATTN_STORE16(Ow+(long)row*PO+ch*8,v);} }
  asm volatile("s_waitcnt lgkmcnt(0)\n\ts_barrier":::"memory");
  #undef DMA_K
  #undef DMA_V
  #undef CMASK
  #undef START
  #undef RESC
  #undef ROT
}
constexpr int ATTN_LDS_BYTES=LDS_BYTES;
#undef SBAR
#undef WAIT_BAR
}
constexpr int DM = 1024, NB = 8, SEQ = 8192, NTOK = NB * SEQ, NIN = 6144, NINP = 6272;
constexpr int C_HQ = 0, C_HF = 512, C_HI = 1024, C_HG = 1536, C_DQ = 2048, C_DK = 2560, C_DV = 3072, C_DG = 3584, C_MA = 4096, C_MB = 5120;
constexpr float RMS_EPS = 1e-6f;
constexpr float QSCALE = 0.125f * 1.4426950408889634f;
constexpr float LAM_INIT = 0.2f;
constexpr size_t MiB = 1u << 20;
constexpr size_t WS_ROWSQ = 20 * MiB  , WS_QCTR = 256 * 1024, WS_MOD = 512 * 1024, WS_WIN = 1 * MiB, WS_WAB = 13 * MiB, WS_WOUT = 15 * MiB, WS_XN = 32 * MiB, WS_PROJ = 160 * MiB, WS_END = 944 * MiB;
constexpr int LDS_BYTES = 147456;
constexpr int NTHR = 512;

typedef unsigned short bf16_t;
typedef short bf16x8 __attribute__((ext_vector_type(8)));
typedef float f32x4 __attribute__((ext_vector_type(4)));
typedef float f32x2 __attribute__((ext_vector_type(2)));
typedef unsigned u32x4 __attribute__((ext_vector_type(4)));
typedef unsigned u32x2 __attribute__((ext_vector_type(2)));

__device__ __forceinline__ float bf2f(unsigned h) { return __uint_as_float(h << 16); }
__device__ __forceinline__ unsigned f2bf(float f) { unsigned u = __float_as_uint(f); return (u + 0x7fffu + ((u >> 16) & 1u)) >> 16; }
__device__ __forceinline__ unsigned pk2(float lo, float hi) { return f2bf(lo) | (f2bf(hi) << 16); }
typedef __bf16 bf16x2_t_ __attribute__((ext_vector_type(2)));
__device__ __forceinline__ unsigned cvtpk(float lo, float hi) { const f32x2 v = {lo, hi}; return __builtin_bit_cast(unsigned, __builtin_convertvector(v, bf16x2_t_)); }
template <int CTRL> __device__ __forceinline__ float dpp_f(float v) { return __int_as_float(__builtin_amdgcn_update_dpp(0, __float_as_int(v), CTRL, 0xf, 0xf, true)); }
template <int M> __device__ __forceinline__ float swz_xor(float v) { return __int_as_float(__builtin_amdgcn_ds_swizzle(__float_as_int(v), (M << 10) | 0x1f)); }
__device__ __forceinline__ float half_sum(float v) { auto rr = __builtin_amdgcn_permlane32_swap(__float_as_uint(v), __float_as_uint(v), false, false); return __uint_as_float(rr[0]) + __uint_as_float(rr[1]); }
__device__ __forceinline__ float wave_sum(float v) { v += swz_xor<1>(v); v += swz_xor<2>(v); v += swz_xor<4>(v); v += swz_xor<8>(v); v += swz_xor<16>(v); return half_sum(v); }
__device__ __forceinline__ float sigmoidf_(float v) { return 1.0f / (1.0f + __expf(-v)); }

struct Params { const float* in[17]; float* out; unsigned char* ws; };
enum { I_X = 0, I_C, I_WADA, I_BADA, I_GPRE, I_GPOST, I_WIN, I_LB, I_HGG, I_LQ1, I_LK1, I_LQ2, I_LK2, I_DNG, I_WA, I_WB, I_WOUT };

struct Ctx {
    unsigned char* lds; int tid, lane, wave, vcu, G;
    bf16_t *WIN, *WAB, *WOUT, *XN, *PROJ, *OAB, *OB4;
    float *ROWSQ, *MOD, *OARAW;
};

__device__ __forceinline__ void transpose_item(const float* __restrict__ W, int N, bf16_t* WT, int ldt, int koff, float* scr, int item, int lane) {
    const int nblk = N / 32, kb = item / nblk, nb = item % nblk, k0 = 64 * kb, n0 = 32 * nb;
#pragma unroll 8
    for (int i = 0; i < 32; ++i) { const int kk = 2 * i + (lane >> 5); scr[kk * 33 + (lane & 31)] = W[(size_t)(k0 + kk) * N + n0 + (lane & 31)]; }
    asm volatile("s_waitcnt lgkmcnt(0)" ::: "memory");
    const int c = lane & 7;
#pragma unroll
    for (int j = 0; j < 4; ++j) { const int n = (lane >> 3) + 8 * j; const float* s = scr + (8 * c) * 33 + n;
        u32x4 o; o.x = pk2(s[0 * 33], s[1 * 33]); o.y = pk2(s[2 * 33], s[3 * 33]); o.z = pk2(s[4 * 33], s[5 * 33]); o.w = pk2(s[6 * 33], s[7 * 33]);
        *(u32x4*)(WT + (size_t)(n0 + n) * ldt + koff + k0 + 8 * c) = o; }
    asm volatile("s_waitcnt lgkmcnt(0)" ::: "memory");
}

__device__ __forceinline__ void phase_prologue(const Params& P, const Ctx& C) {
    if (C.vcu < 48) {
        float* sc = (float*)(C.lds + 69632); float* red = (float*)(C.lds + 102400);
        const float* cc = P.in[I_C];
        for (int i = C.tid; i < NB * DM; i += NTHR) { const float v = cc[i]; sc[i] = v * sigmoidf_(v); }
        __syncthreads();
        const int n = C.vcu * 64 + C.lane; const float* wa = P.in[I_WADA];
        float acc[NB];
#pragma unroll
        for (int b = 0; b < NB; ++b) acc[b] = 0.f;
#pragma unroll 16
        for (int kk = 0; kk < 128; ++kk) { const int k = C.wave * 128 + kk; const float w = wa[(size_t)k * 3072 + n];
#pragma unroll
            for (int b = 0; b < NB; ++b) acc[b] += sc[b * DM + k] * w; }
#pragma unroll
        for (int b = 0; b < NB; ++b) red[(C.wave * NB + b) * 64 + C.lane] = acc[b];
        __syncthreads();
        { const int bb = C.tid >> 6; float s = 0.f;
#pragma unroll
          for (int w = 0; w < 8; ++w) s += red[(w * NB + bb) * 64 + C.lane];
          C.MOD[bb * 3072 + n] = s + P.in[I_BADA][n]; }
        __syncthreads();
    }
    float* scr = (float*)(C.lds + C.wave * 8448);
    const int gw = C.vcu * 8 + C.wave, NGW = C.G * 8;
    constexpr int IT_IN = 16 * 192, IT_A = 8 * 32, IT_B = 8 * 32, IT_O = 16 * 32;
    for (int it = gw; it < IT_IN + IT_A + IT_B + IT_O; it += NGW) {
        int r = it;
        if (r < IT_IN) { transpose_item(P.in[I_WIN], NIN, C.WIN, DM, 0, scr, r, C.lane); continue; } r -= IT_IN;
        if (r < IT_A) { transpose_item(P.in[I_WA], DM, C.WAB, DM, 0, scr, r, C.lane); continue; } r -= IT_A;
        if (r < IT_B) { transpose_item(P.in[I_WB], DM, C.WAB, DM, 512, scr, r, C.lane); continue; } r -= IT_B;
        transpose_item(P.in[I_WOUT], DM, C.WOUT, DM, 0, scr, r, C.lane);
    }
    if (blockIdx.x == 2) {
        float* aux = C.MOD + 24576;
        if (C.wave == 0) { const float lam = __expf(wave_sum(P.in[I_LQ1][C.lane] * P.in[I_LK1][C.lane])) - __expf(wave_sum(P.in[I_LQ2][C.lane] * P.in[I_LK2][C.lane])) + LAM_INIT; if (C.lane == 0) aux[0] = lam; }
        aux[64 + C.tid] = P.in[I_DNG][C.tid];
    }

}

__device__ __forceinline__ void phase_prenorm(const Params& P, const Ctx& C) {
    const int gw = C.vcu * 8 + C.wave, NGW = C.G * 8;
    const float* gp = P.in[I_GPRE];
    for (int m4 = gw; m4 < NTOK / 4; m4 += NGW) {
        const int m = m4 * 4, b = m >> 13;
        const f32x4* xr = (const f32x4*)(P.in[I_X] + (size_t)m * DM) + C.lane;
        f32x4 v[16]; float ss[4];
#pragma unroll
        for (int j = 0; j < 16; ++j) v[j] = __builtin_nontemporal_load(xr + 64 * j);
#pragma unroll
        for (int r = 0; r < 4; ++r) { float a = 0.f;
#pragma unroll
            for (int j = 0; j < 4; ++j) { const f32x4 t = v[4 * r + j]; a += (t.x * t.x + t.y * t.y) + (t.z * t.z + t.w * t.w); }
            ss[r] = rsqrtf(wave_sum(a) * (1.f / DM) + RMS_EPS); }
        u32x2* o8 = (u32x2*)(C.XN + (size_t)m * DM) + C.lane;
#pragma unroll
        for (int j = 0; j < 4; ++j) { const int idx = (C.lane + 64 * j) * 4;
            const f32x4 g = *(const f32x4*)(gp + idx), sh = *(const f32x4*)(C.MOD + b * 3072 + idx), sc = *(const f32x4*)(C.MOD + b * 3072 + 1024 + idx);
            const f32x4 gs = g * (sc + 1.0f);
#pragma unroll
            for (int r = 0; r < 4; ++r) { const f32x4 h = v[4 * r + j] * ss[r] * gs + sh;
                u32x2 o; o.x = cvtpk(h.x, h.y); o.y = cvtpk(h.z, h.w); o8[r * 256 + 64 * j] = o; } }
    }
}

template <class Epi>
__device__ __forceinline__ void gemm_simple(const bf16_t* __restrict__ A, int lda, const bf16_t* __restrict__ Bt, int ldb, int M, int N, int K, const Ctx& C, const Epi& E) {
    const int fr = C.lane & 15, fq = C.lane >> 4, wm = C.wave >> 2, wn = C.wave & 3;
    const int ntn = N / 256, ntiles = (M / 128) * ntn;
    for (int tile = C.vcu; tile < ntiles; tile += C.G) {
        const int tm = tile / ntn, tn = tile % ntn, m0 = tm * 128 + wm * 64, n0 = tn * 256 + wn * 64;
        f32x4 acc[4][4];
#pragma unroll
        for (int i = 0; i < 4; ++i)
#pragma unroll
            for (int j = 0; j < 4; ++j) acc[i][j] = (f32x4){0.f, 0.f, 0.f, 0.f};
        const bf16_t* ap = A + (size_t)(m0 + fr) * lda + fq * 8; const bf16_t* bp = Bt + (size_t)(n0 + fr) * ldb + fq * 8;
        for (int k0 = 0; k0 < K; k0 += 32) {
            if (Epi::MID) { if (k0 == K / 2) E.mid(acc, m0, n0, fr, fq); }
            bf16x8 a[4], b[4];
#pragma unroll
            for (int i = 0; i < 4; ++i) { a[i] = *(const bf16x8*)(ap + (size_t)i * 16 * lda + k0); b[i] = *(const bf16x8*)(bp + (size_t)i * 16 * ldb + k0); }
#pragma unroll
            for (int mi = 0; mi < 4; ++mi)
#pragma unroll
                for (int ni = 0; ni < 4; ++ni) acc[mi][ni] = __builtin_amdgcn_mfma_f32_16x16x32_bf16(b[ni], a[mi], acc[mi][ni], 0, 0, 0);
        }
        E(acc, m0, n0, fr, fq);
    }
}
struct EpiProj {
    static constexpr bool MID = false; bf16_t* O;
    __device__ __forceinline__ void mid(f32x4 (&)[4][4], int, int, int, int) const {}
    __device__ __forceinline__ void operator()(const f32x4 (&acc)[4][4], int m0, int n0, int fr, int fq) const {
        const float sc = (n0 >= C_DQ && n0 < C_DK) ? QSCALE : 1.0f;
#pragma unroll
        for (int mi = 0; mi < 4; ++mi)
#pragma unroll
            for (int ni = 0; ni < 4; ++ni) { const f32x4 v = acc[mi][ni] * sc; u32x2 o; o.x = pk2(v.x, v.y); o.y = pk2(v.z, v.w);
                *(u32x2*)(O + (size_t)(m0 + 16 * mi + fr) * NINP + n0 + 16 * ni + 4 * fq) = o; }
    }
};
struct EpiMerge {
    static constexpr bool MID = true; const bf16_t* PROJ; bf16_t* Y;
    __device__ __forceinline__ void mid(f32x4 (&acc)[4][4], int m0, int n0, int fr, int fq) const {
#pragma unroll
        for (int mi = 0; mi < 4; ++mi)
#pragma unroll
            for (int ni = 0; ni < 4; ++ni) { const bf16_t* p = PROJ + (size_t)(m0 + 16 * mi + fr) * NINP + n0 + 16 * ni + 4 * fq;
                const u32x2 a = *(const u32x2*)(p + C_MA), b = *(const u32x2*)(p + C_MB);
                const float a0 = bf2f(a.x & 0xffffu), a1 = bf2f(a.x >> 16), a2 = bf2f(a.y & 0xffffu), a3 = bf2f(a.y >> 16);
                const float b0 = bf2f(b.x & 0xffffu), b1 = bf2f(b.x >> 16), b2 = bf2f(b.y & 0xffffu), b3 = bf2f(b.y >> 16);
                f32x4 r; r.x = (1.f + __expf(-b0)) / (1.f + __expf(-a0)); r.y = (1.f + __expf(-b1)) / (1.f + __expf(-a1));
                r.z = (1.f + __expf(-b2)) / (1.f + __expf(-a2)); r.w = (1.f + __expf(-b3)) / (1.f + __expf(-a3));
                acc[mi][ni] = acc[mi][ni] * r; }
    }
    __device__ __forceinline__ void operator()(const f32x4 (&acc)[4][4], int m0, int n0, int fr, int fq) const {
#pragma unroll
        for (int mi = 0; mi < 4; ++mi)
#pragma unroll
            for (int ni = 0; ni < 4; ++ni) { const size_t off = (size_t)(m0 + 16 * mi + fr) * NINP + n0 + 16 * ni + 4 * fq;
                const u32x2 b = *(const u32x2*)(PROJ + off + C_MB);
                f32x4 s; s.x = sigmoidf_(bf2f(b.x & 0xffffu)); s.y = sigmoidf_(bf2f(b.x >> 16)); s.z = sigmoidf_(bf2f(b.y & 0xffffu)); s.w = sigmoidf_(bf2f(b.y >> 16));
                const f32x4 v = acc[mi][ni] * s; u32x2 o; o.x = pk2(v.x, v.y); o.y = pk2(v.z, v.w);
                *(u32x2*)(Y + off) = o; }
    }
};
struct EpiZ {
    static constexpr bool MID = false; float* Z; float* ROWSQ;
    __device__ __forceinline__ void mid(f32x4 (&)[4][4], int, int, int, int) const {}
    __device__ __forceinline__ void operator()(const f32x4 (&acc)[4][4], int m0, int n0, int fr, int fq) const {
#pragma unroll
        for (int mi = 0; mi < 4; ++mi) { float s = 0.f;
#pragma unroll
            for (int ni = 0; ni < 4; ++ni) { const f32x4 v = acc[mi][ni]; s += (v.x * v.x + v.y * v.y) + (v.z * v.z + v.w * v.w);
                *(f32x4*)(Z + (size_t)(m0 + 16 * mi + fr) * DM + n0 + 16 * ni + 4 * fq) = v; }
            s += swz_xor<16>(s); s = half_sum(s);
            if (fq == 0) atomicAdd(ROWSQ + m0 + 16 * mi + fr, s); }
    }
};


struct EpiProj2 {
    static constexpr bool PERM = true, AFTER_DRAIN = false, MID = false, POST = false; bf16_t* O; bf16_t* KH; bf16_t* VH;
    __device__ __forceinline__ void mid(f32x4 (&)[2][2][4][2], const pg8::Unit&, int, int, int, int) const {}
    __device__ __forceinline__ void operator()(const f32x4 (&acc)[2][2][4][2], const pg8::Unit& u, int wr, int wc, int fr, int fq) const {
        const float sc = (u.pn == 8 || u.pn == 9) ? QSCALE : 1.0f;
        const bool gate = u.pn >= 16;
        const int row0 = u.pm * 256 + wr * 64 + fr, col0 = u.pn * 256 + wc * 32 + 8 * fq;
        if (u.pn >= 10 && u.pn < 14) {
            const bool isk = u.pn < 12; const int b = row0 >> 13, t0 = row0 & (SEQ - 1);
#pragma unroll
            for (int bj = 0; bj < 2; ++bj) { const int c = col0 + bj * 128 - (isk ? C_DK : C_DV);
                bf16_t* hp = isk ? KH + ((size_t)(b * 8 + (c >> 6)) * SEQ + t0) * 64 + (c & 63) : VH + ((size_t)(b * 4 + (c >> 7)) * SEQ + t0) * 128 + (c & 127);
                const int pitch = isk ? 64 : 128;
#pragma unroll
                for (int ai = 0; ai < 2; ++ai)
#pragma unroll
                    for (int m = 0; m < 4; ++m) { const f32x4 v0 = acc[ai][bj][m][0], v1 = acc[ai][bj][m][1];
                        u32x4 w; w.x = cvtpk(v0[0], v0[1]); w.y = cvtpk(v0[2], v0[3]); w.z = cvtpk(v1[0], v1[1]); w.w = cvtpk(v1[2], v1[3]);
                        *(u32x4*)(hp + (size_t)(ai * 128 + m * 16) * pitch) = w; } }
            return;
        }
#pragma unroll
        for (int ai = 0; ai < 2; ++ai)
#pragma unroll
            for (int m = 0; m < 4; ++m) { bf16_t* rowp = O + (size_t)(row0 + ai * 128 + m * 16) * NINP + col0;
#pragma unroll
                for (int bj = 0; bj < 2; ++bj) { f32x4 v0 = acc[ai][bj][m][0] * sc, v1 = acc[ai][bj][m][1] * sc;
                    if (gate) {
#pragma unroll
                        for (int i = 0; i < 4; ++i) { v0[i] = 1.0f + __expf(-fminf(fmaxf(v0[i], -60.f), 60.f)); v1[i] = 1.0f + __expf(-fminf(fmaxf(v1[i], -60.f), 60.f)); } }
                    u32x4 w; w.x = cvtpk(v0[0], v0[1]); w.y = cvtpk(v0[2], v0[3]); w.z = cvtpk(v1[0], v1[1]); w.w = cvtpk(v1[2], v1[3]);
                    *(u32x4*)(rowp + bj * 128) = w; } }
    }
};
__device__ __forceinline__ void unpack8(const u32x4 a, float (&f)[8]) {
    f[0] = bf2f(a.x & 0xffffu); f[1] = bf2f(a.x >> 16); f[2] = bf2f(a.y & 0xffffu); f[3] = bf2f(a.y >> 16);
    f[4] = bf2f(a.z & 0xffffu); f[5] = bf2f(a.z >> 16); f[6] = bf2f(a.w & 0xffffu); f[7] = bf2f(a.w >> 16);
}
struct EpiMerge2 {
    static constexpr bool PERM = true, AFTER_DRAIN = false, MID = true, POST = false; const bf16_t* PROJ; bf16_t* Y;
    __device__ __forceinline__ void mid(f32x4 (&acc)[2][2][4][2], const pg8::Unit& u, int wr, int wc, int fr, int fq) const {
        asm volatile("" : "+v"(fr), "+v"(fq));
        const int row0 = u.pm * 256 + wr * 64 + fr, col0 = u.pn * 256 + wc * 32 + 8 * fq;
#pragma unroll
        for (int ai = 0; ai < 2; ++ai)
#pragma unroll
            for (int m = 0; m < 4; ++m) { const bf16_t* rowp = PROJ + (size_t)(row0 + ai * 128 + m * 16) * NINP + col0;
#pragma unroll
                for (int bj = 0; bj < 2; ++bj) { float a[8], b[8]; unpack8(*(const u32x4*)(rowp + C_MA + bj * 128), a); unpack8(*(const u32x4*)(rowp + C_MB + bj * 128), b);
                    float r[8];
#pragma unroll
                    for (int i = 0; i < 8; ++i) r[i] = b[i] * __builtin_amdgcn_rcpf(a[i]);
                    acc[ai][bj][m][0] = acc[ai][bj][m][0] * (f32x4){r[0], r[1], r[2], r[3]}; acc[ai][bj][m][1] = acc[ai][bj][m][1] * (f32x4){r[4], r[5], r[6], r[7]}; }
                asm volatile("" : "+v"(acc[ai][0][m][0]), "+v"(acc[ai][0][m][1]), "+v"(acc[ai][1][m][0]), "+v"(acc[ai][1][m][1]) :: "memory"); }
    }
    __device__ __forceinline__ void operator()(const f32x4 (&acc)[2][2][4][2], const pg8::Unit& u, int wr, int wc, int fr, int fq) const {
        asm volatile("" : "+v"(fr), "+v"(fq));
        const int row0 = u.pm * 256 + wr * 64 + fr, col0 = u.pn * 256 + wc * 32 + 8 * fq;
#pragma unroll
        for (int ai = 0; ai < 2; ++ai)
#pragma unroll
            for (int m = 0; m < 4; ++m) { const size_t off = (size_t)(row0 + ai * 128 + m * 16) * NINP + col0;
#pragma unroll
                for (int bj = 0; bj < 2; ++bj) { float b[8]; unpack8(*(const u32x4*)(PROJ + off + C_MB + bj * 128), b);
#pragma unroll
                    for (int i = 0; i < 8; ++i) b[i] = __builtin_amdgcn_rcpf(b[i]);
                    const f32x4 v0 = acc[ai][bj][m][0] * (f32x4){b[0], b[1], b[2], b[3]}, v1 = acc[ai][bj][m][1] * (f32x4){b[4], b[5], b[6], b[7]};
                    u32x4 w; w.x = cvtpk(v0[0], v0[1]); w.y = cvtpk(v0[2], v0[3]); w.z = cvtpk(v1[0], v1[1]); w.w = cvtpk(v1[2], v1[3]);
                    *(u32x4*)(Y + (size_t)(row0 + ai * 128 + m * 16) * DM + col0 + bj * 128) = w; }
                asm volatile("" ::: "memory"); }
    }
};
struct EpiZ2 {
    static constexpr bool PERM = true, AFTER_DRAIN = false, MID = false, POST = false; bf16_t* ZB; float* ROWSQ;
    __device__ __forceinline__ void mid(f32x4 (&)[2][2][4][2], const pg8::Unit&, int, int, int, int) const {}
    __device__ __forceinline__ void operator()(const f32x4 (&acc)[2][2][4][2], const pg8::Unit& u, int wr, int wc, int fr, int fq) const {
        const int row0 = u.pm * 256 + wr * 64 + fr, col0 = u.pn * 256 + wc * 32 + 8 * fq;
#pragma unroll
        for (int ai = 0; ai < 2; ++ai)
#pragma unroll
            for (int m = 0; m < 4; ++m) { const int row = row0 + ai * 128 + m * 16; float s = 0.f;
#pragma unroll
                for (int bj = 0; bj < 2; ++bj) { const f32x4 v0 = acc[ai][bj][m][0], v1 = acc[ai][bj][m][1];
                    s += ((v0.x * v0.x + v0.y * v0.y) + (v0.z * v0.z + v0.w * v0.w)) + ((v1.x * v1.x + v1.y * v1.y) + (v1.z * v1.z + v1.w * v1.w));
                    u32x4 w; w.x = cvtpk(v0[0], v0[1]); w.y = cvtpk(v0[2], v0[3]); w.z = cvtpk(v1[0], v1[1]); w.w = cvtpk(v1[2], v1[3]);
                    *(u32x4*)(ZB + (size_t)row * NINP + col0 + bj * 128) = w; }
                s += swz_xor<16>(s); s = half_sum(s);
                if (fq == 0) ROWSQ[(size_t)row * 16 + u.pn * 4 + wc] = s; }
    }
};

__device__ __forceinline__ void phase_hgrn_naive(const Params& P, const Ctx& C) {
    float* qs = (float*)C.lds; float* fs = qs + 8192; float* ks = fs + 8192; float* vs = ks + 8192; float* part = vs + 1024; float* lbs = part + 8192;
    const int e = C.tid & 15, dg = C.tid >> 4;
    for (int unit = C.vcu; unit < 256; unit += C.G) {
        const int b = unit >> 5, h = (unit >> 3) & 3, es = unit & 7;
        __syncthreads();
        if (C.tid < 128) { const float l0 = P.in[I_LB][h * 128 + C.tid], l1 = P.in[I_LB][512 + h * 128 + C.tid]; lbs[C.tid] = 1.0f / (1.0f + __expf(l1 - l0)); }
        __syncthreads();
        float S0 = 0.f, S1 = 0.f, S2 = 0.f, S3 = 0.f;
        for (int c = 0; c < SEQ / 64; ++c) {
            const size_t row0 = (size_t)b * SEQ + c * 64;
#pragma unroll 4
            for (int j = 0; j < 16; ++j) { const int idx = C.tid + NTHR * j, t = idx >> 7, d = idx & 127;
                const bf16_t* p = C.PROJ + (row0 + t) * NINP + h * 128 + d;
                const float q = bf2f(p[C_HQ]), fz = bf2f(p[C_HF]), sg = sigmoidf_(fz), lb = lbs[d];
                qs[idx] = q; fs[idx] = lb + (1.f - lb) * sg; ks[idx] = (1.f - lb) * sigmoidf_(-fz); }
#pragma unroll
            for (int j = 0; j < 2; ++j) { const int idx = C.tid + NTHR * j, t = idx >> 4, ee = idx & 15;
                vs[idx] = bf2f(C.PROJ[(row0 + t) * NINP + C_HI + h * 128 + es * 16 + ee]); }
            __syncthreads();
            for (int t = 0; t < 64; ++t) {
                const f32x4 f4 = *(const f32x4*)(fs + t * 128 + dg * 4), k4 = *(const f32x4*)(ks + t * 128 + dg * 4), q4 = *(const f32x4*)(qs + t * 128 + dg * 4);
                const float v = vs[t * 16 + e];
                S0 = f4.x * S0 + k4.x * v; S1 = f4.y * S1 + k4.y * v; S2 = f4.z * S2 + k4.z * v; S3 = f4.w * S3 + k4.w * v;
                float po = (S0 * q4.x + S1 * q4.y) + (S2 * q4.z + S3 * q4.w);
                po += swz_xor<16>(po); po = half_sum(po);
                if (C.lane < 16) part[(t * 8 + C.wave) * 16 + C.lane] = po;
            }
            __syncthreads();
#pragma unroll
            for (int j = 0; j < 2; ++j) { const int idx = C.tid + NTHR * j, t = idx >> 4, ee = idx & 15; float s = 0.f;
#pragma unroll
                for (int w = 0; w < 8; ++w) s += part[(t * 8 + w) * 16 + ee];
                C.OARAW[(row0 + t) * 512 + h * 128 + es * 16 + ee] = s; }
            __syncthreads();
        }
    }
}


constexpr int HG_QH = 0, HG_KH = 17408, HG_KT = 34816, HG_VT = 53248, HG_PS = 71680, HG_ST = 80896, HG_SEG = 115712, HG_E31 = 117760, HG_E63 = 118272, HG_ROWP = 118784;
constexpr int HG_RQ = HG_PS, HG_RF = HG_PS + 16384, HG_RV = HG_QH, HG_RG = 120832;
static_assert(HG_RF + 16384 <= HG_SEG && 16384 <= HG_KH - HG_QH && HG_RG + 16384 <= LDS_BYTES - 64, "raw tile aliases");
#define HG_BAR() do { asm volatile("s_waitcnt lgkmcnt(0)" ::: "memory"); __builtin_amdgcn_s_barrier(); asm volatile("" ::: "memory"); } while (0)
__device__ __forceinline__ void hgrn_chain(const Params& P, const Ctx& C, int b, int h) {
    unsigned char* L = C.lds;
    int tid_ = C.tid; asm volatile("" : "+v"(tid_));
    const int tid = tid_, lane = tid & 63, w = C.wave, fr = lane & 15, fq = lane >> 4, col = tid & 127, seg = tid >> 7;
    bf16_t* QH = (bf16_t*)(L + HG_QH); bf16_t* KH = (bf16_t*)(L + HG_KH); bf16_t* KT = (bf16_t*)(L + HG_KT); bf16_t* VT = (bf16_t*)(L + HG_VT);
    bf16_t* PS = (bf16_t*)(L + HG_PS); bf16_t* STw = (bf16_t*)(L + HG_ST + w * 4352);
    const bf16_t* RQ = (const bf16_t*)(L + HG_RQ); const bf16_t* RF = (const bf16_t*)(L + HG_RF); const bf16_t* RV = (const bf16_t*)(L + HG_RV); const bf16_t* RG = (const bf16_t*)(L + HG_RG);
    float* SEG = (float*)(L + HG_SEG); float* E31 = (float*)(L + HG_E31); float* E63 = (float*)(L + HG_E63); float* ROWT = (float*)(L + HG_ROWP);
    const float lb = 1.0f / (1.0f + __expf(P.in[I_LB][512 + h * 128 + col] - P.in[I_LB][h * 128 + col]));
#define omlb (1.0f - lb)
    const bf16_t* base = C.PROJ + (size_t)b * SEQ * NINP + h * 128;
    bf16_t* obase = C.OAB + (size_t)b * SEQ * DM + h * 128;
    f32x4 Sacc[8];
#pragma unroll
    for (int j = 0; j < 8; ++j) Sacc[j] = (f32x4){0.f, 0.f, 0.f, 0.f};
    const int r0 = tid >> 4, pc = (tid & 15) * 8;
    u32x4 pq[1][2], pf[1][2], pv[1][2], pg[1][2];
    int loff = r0 * NINP + pc;
#define HG_LOAD(s_, c_) do { const bf16_t* p_ = base + (size_t)(c_) * 64 * NINP; _Pragma("unroll") for (int k_ = 0; k_ < 2; ++k_) { const bf16_t* q_ = p_ + (loff + k_ * 32 * NINP); \
        pq[s_][k_] = *(const u32x4*)(q_ + C_HQ); pf[s_][k_] = *(const u32x4*)(q_ + C_HF); pv[s_][k_] = *(const u32x4*)(q_ + C_HI); pg[s_][k_] = *(const u32x4*)(q_ + C_HG); } } while (0)
    HG_LOAD(0, 0);
    for (int c = 0; c < SEQ / 64; ++c) {
      { constexpr int hs = 0;
        const int row0 = c * 64;
#pragma unroll
        for (int k = 0; k < 2; ++k) { const int o_ = (r0 + 32 * k) * 128 + pc;
            *(u32x4*)(L + HG_RQ + o_ * 2) = pq[hs][k]; *(u32x4*)(L + HG_RF + o_ * 2) = pf[hs][k]; *(u32x4*)(L + HG_RV + o_ * 2) = pv[hs][k]; *(u32x4*)(L + HG_RG + o_ * 2) = pg[hs][k]; }
        if (c + 1 < SEQ / 64) { asm volatile("" : "+v"(loff)); HG_LOAD(hs, c + 1); }
        HG_BAR();
        float sgv[16]; float run = 1.f;
        { unsigned vt[8];
#pragma unroll
          for (int i = 0; i < 16; ++i) { const int ro = (16 * seg + i) * 128 + col; float fz = bf2f(RF[ro]); fz = fminf(fmaxf(fz, -30.f), 30.f);
              const float sg = __builtin_amdgcn_rcpf(1.f + __expf(-fz));
              sgv[i] = sg; run *= (lb + omlb * sg);
              const unsigned v = RV[ro]; if (i & 1) vt[i >> 1] |= v << 16; else vt[i >> 1] = v; }
          *(u32x4*)(VT + col * 72 + seg * 16) = (u32x4){vt[0], vt[1], vt[2], vt[3]}; *(u32x4*)(VT + col * 72 + seg * 16 + 8) = (u32x4){vt[4], vt[5], vt[6], vt[7]}; }
        SEG[seg * 128 + col] = run;
        if (tid < 64) ROWT[tid] = 0.f;
        HG_BAR();
        { const float s0 = SEG[col], s1 = SEG[128 + col], s2 = SEG[256 + col], s3 = SEG[384 + col];
          const float p31 = s0 * s1, p6331 = s2 * s3;
          float g = (seg == 0) ? __builtin_amdgcn_rcpf(p31) : (seg == 1) ? __builtin_amdgcn_rcpf(s1) : (seg == 2) ? 1.0f : s2;
          unsigned kt[8];
#pragma unroll
          for (int i = 0; i < 16; i += 2) {
              g *= (lb + omlb * sgv[i]); const float g0 = g; g *= (lb + omlb * sgv[i + 1]); const float g1 = g;
              const float kh0 = (omlb - omlb * sgv[i]) * __builtin_amdgcn_rcpf(g0), kh1 = (omlb - omlb * sgv[i + 1]) * __builtin_amdgcn_rcpf(g1);
              const unsigned qw = cvtpk(bf2f(RQ[(16 * seg + i) * 128 + col]) * g0, bf2f(RQ[(16 * seg + i + 1) * 128 + col]) * g1), kw = cvtpk(kh0, kh1);
              QH[(16 * seg + i) * 136 + col] = (bf16_t)(qw & 0xffffu); QH[(16 * seg + i + 1) * 136 + col] = (bf16_t)(qw >> 16);
              KH[(16 * seg + i) * 136 + col] = (bf16_t)(kw & 0xffffu); KH[(16 * seg + i + 1) * 136 + col] = (bf16_t)(kw >> 16);
              kt[i >> 1] = cvtpk(kh0 * p6331, kh1 * p6331); }
          *(u32x4*)(KT + col * 72 + seg * 16) = (u32x4){kt[0], kt[1], kt[2], kt[3]}; *(u32x4*)(KT + col * 72 + seg * 16 + 8) = (u32x4){kt[4], kt[5], kt[6], kt[7]};
          if (seg == 0) { E31[col] = p31; E63[col] = p31 * p6331; } }
        HG_BAR();
#pragma unroll
        for (int j = 0; j < 8; ++j) { const float ev = E31[16 * j + fr];
#pragma unroll
            for (int i = 0; i < 4; i += 2) { const unsigned sw = cvtpk(Sacc[j][i] * ev, Sacc[j][i + 1] * ev);
                STw[(4 * fq + i) * 136 + 16 * j + fr] = (bf16_t)(sw & 0xffffu); STw[(4 * fq + i + 1) * 136 + 16 * j + fr] = (bf16_t)(sw >> 16); } }
#pragma unroll
        for (int q = 0; q < 2; ++q) { const int tt = 2 * w + q, ti = tt >> 2, sj = tt & 3; f32x4 pa = (f32x4){0.f, 0.f, 0.f, 0.f};
            if (sj <= ti) {
#pragma unroll
                for (int k4 = 0; k4 < 4; ++k4) { const bf16x8 a = *(const bf16x8*)(QH + (16 * ti + fr) * 136 + 32 * k4 + 8 * fq), bb = *(const bf16x8*)(KH + (16 * sj + fr) * 136 + 32 * k4 + 8 * fq);
                    pa = __builtin_amdgcn_mfma_f32_16x16x32_bf16(a, bb, pa, 0, 0, 0); }
                if (sj == ti) {
#pragma unroll
                    for (int i = 0; i < 4; ++i) if (fr > 4 * fq + i) pa[i] = 0.f; }
            }
            const unsigned w0 = cvtpk(pa[0], pa[1]), w1 = cvtpk(pa[2], pa[3]); bf16_t* pp = PS + (16 * ti + 4 * fq) * 72 + 16 * sj + fr;
            pp[0] = (bf16_t)(w0 & 0xffffu); pp[72] = (bf16_t)(w0 >> 16); pp[144] = (bf16_t)(w1 & 0xffffu); pp[216] = (bf16_t)(w1 >> 16); }
        f32x4 o[4];
#pragma unroll
        for (int mt = 0; mt < 4; ++mt) o[mt] = (f32x4){0.f, 0.f, 0.f, 0.f};
#pragma unroll
        for (int k4 = 0; k4 < 4; ++k4) { const bf16x8 bs = *(const bf16x8*)(STw + fr * 136 + 32 * k4 + 8 * fq);
#pragma unroll
            for (int mt = 0; mt < 4; ++mt) { const bf16x8 a = *(const bf16x8*)(QH + (16 * mt + fr) * 136 + 32 * k4 + 8 * fq); o[mt] = __builtin_amdgcn_mfma_f32_16x16x32_bf16(a, bs, o[mt], 0, 0, 0); } }
        HG_BAR();
        bf16x8 vf[2];
#pragma unroll
        for (int k2 = 0; k2 < 2; ++k2) vf[k2] = *(const bf16x8*)(VT + (16 * w + fr) * 72 + 32 * k2 + 8 * fq);
#pragma unroll
        for (int k2 = 0; k2 < 2; ++k2)
#pragma unroll
            for (int mt = 0; mt < 4; ++mt) { if (k2 == 1 && mt < 2) continue;
                const bf16x8 a = *(const bf16x8*)(PS + (16 * mt + fr) * 72 + 32 * k2 + 8 * fq); o[mt] = __builtin_amdgcn_mfma_f32_16x16x32_bf16(a, vf[k2], o[mt], 0, 0, 0); }
#pragma unroll
        for (int j = 0; j < 8; ++j) { const float ev = E63[16 * j + fr]; Sacc[j] = Sacc[j] * ev;
#pragma unroll
            for (int k2 = 0; k2 < 2; ++k2) { const bf16x8 bk = *(const bf16x8*)(KT + (16 * j + fr) * 72 + 32 * k2 + 8 * fq); Sacc[j] = __builtin_amdgcn_mfma_f32_16x16x32_bf16(vf[k2], bk, Sacc[j], 0, 0, 0); } }
#pragma unroll
        for (int mt = 0; mt < 4; ++mt)
#pragma unroll
            for (int i = 0; i < 4; ++i) { float ss = o[mt][i] * o[mt][i];
                ss += dpp_f<0x128>(ss); ss += dpp_f<0x124>(ss); ss += dpp_f<0x4E>(ss); ss += dpp_f<0xB1>(ss);
                if (fr == 0) atomicAdd(ROWT + 16 * mt + 4 * fq + i, ss); }
        unsigned rg[8];
#pragma unroll
        for (int mt = 0; mt < 4; ++mt)
#pragma unroll
            for (int i = 0; i < 4; i += 2) rg[mt * 2 + (i >> 1)] = (unsigned)RG[(16 * mt + 4 * fq + i) * 128 + 16 * w + fr] | ((unsigned)RG[(16 * mt + 4 * fq + i + 1) * 128 + 16 * w + fr] << 16);
        HG_BAR();
        f32x4 rt4[4];
#pragma unroll
        for (int mt = 0; mt < 4; ++mt) rt4[mt] = *(const f32x4*)(ROWT + 16 * mt + 4 * fq);
        int ocol = 16 * w + fr; asm volatile("" : "+v"(ocol)); const float gain = P.in[I_HGG][h * 128 + ocol];
        bf16_t* const orow = obase + (size_t)row0 * DM;
#pragma unroll
        for (int mt = 0; mt < 4; ++mt)
#pragma unroll
            for (int i = 0; i < 4; ++i) { const int t = 16 * mt + 4 * fq + i;
                const float r = rsqrtf(rt4[mt][i] * (1.f / 128.f) + RMS_EPS);
                const float g = (i & 1) ? bf2f(rg[mt * 2 + (i >> 1)] >> 16) : bf2f(rg[mt * 2 + (i >> 1)] & 0xffffu);
                orow[t * DM + ocol] = (bf16_t)f2bf(o[mt][i] * r * gain * (g * sigmoidf_(g))); }
      }
    }
    HG_BAR();
#undef HG_LOAD
#undef omlb
}

__device__ __forceinline__ void phase_attn(const Ctx& C, unsigned* ctr) {
    volatile unsigned* word = (volatile unsigned*)(C.lds + LDS_BYTES - 64);
    if (C.tid == 0) word[0] = atomicAdd(ctr, 1u);
    __syncthreads();
    unsigned cur = (unsigned)__builtin_amdgcn_readfirstlane((int)word[0]);
    for (int it = 0; cur < 4096u; ++it) {
        unsigned s_nx = 0u;
        if (C.wave == 0) { unsigned nx = 0u; if (C.lane == 0) nx = atomicAdd(ctr, 1u); s_nx = (unsigned)__builtin_amdgcn_readfirstlane((int)nx); }
        const int qb = 31 - (int)(cur >> 7), vhd = (int)(cur & 127u);
        const int b = vhd >> 4, h = (vhd >> 2) & 3, j = (vhd >> 1) & 1, vh = vhd & 1;
        const attn_body::bf16* Q = (const attn_body::bf16*)(C.PROJ + C_DQ + (h * 2 + j) * 64);
        const attn_body::bf16* K = (const attn_body::bf16*)(C.OARAW) + (size_t)(b * 8 + h * 2 + j) * SEQ * 64;
        const attn_body::bf16* V = (const attn_body::bf16*)(C.OARAW) + (size_t)32 * 1024 * 1024 + (size_t)(b * 4 + h) * SEQ * 128 + vh * 64;
        attn_body::bf16* O = (attn_body::bf16*)(C.OB4 + (h * 2 + j) * 128 + vh * 64);
        attn_body::attn_unit<8>(b, C.tid, qb, Q, K, V, O, (char*)C.lds);
        if (C.tid == 0) word[(it + 1) & 1] = s_nx;
        asm volatile("s_waitcnt lgkmcnt(0)" ::: "memory"); __builtin_amdgcn_s_barrier(); asm volatile("" ::: "memory");
        cur = (unsigned)__builtin_amdgcn_readfirstlane((int)word[(it + 1) & 1]);
    }
}

__device__ __forceinline__ void phase_branch_norm(const Params& P, const Ctx& C) {
    const int gw = C.vcu * 8 + C.wave, NGW = C.G * 8, l16 = C.lane & 15, rs = C.lane >> 4;
    const float* aux = C.MOD + 24576; const float lam = aux[0];
    for (int t4 = gw; t4 < NTOK / 4; t4 += NGW) {
        const size_t m = (size_t)t4 * 4 + rs;
#pragma unroll
        for (int h = 0; h < 4; ++h) {
            const f32x4 gn0 = *(const f32x4*)(aux + 64 + h * 128 + 8 * l16), gn1 = *(const f32x4*)(aux + 64 + h * 128 + 8 * l16 + 4);
            float o1[8], o2[8], g[8];
            unpack8(*(const u32x4*)(C.OB4 + m * DM + (h * 2 + 0) * 128 + 8 * l16), o1); unpack8(*(const u32x4*)(C.OB4 + m * DM + (h * 2 + 1) * 128 + 8 * l16), o2);
            unpack8(*(const u32x4*)(C.PROJ + m * NINP + C_DG + h * 128 + 8 * l16), g);
            float ss = 0.f;
#pragma unroll
            for (int i = 0; i < 8; ++i) { o1[i] -= lam * o2[i]; ss += o1[i] * o1[i]; }
            ss += swz_xor<1>(ss); ss += swz_xor<2>(ss); ss += swz_xor<4>(ss); ss += swz_xor<8>(ss);
            const float r = rsqrtf(ss * (1.f / 128.f) + RMS_EPS) * (1.0f - LAM_INIT);
            const float gv[8] = {gn0.x, gn0.y, gn0.z, gn0.w, gn1.x, gn1.y, gn1.z, gn1.w};
#pragma unroll
            for (int i = 0; i < 8; ++i) o1[i] = o1[i] * r * gv[i] * (g[i] * sigmoidf_(g[i]));
            u32x4 wv4; wv4.x = cvtpk(o1[0], o1[1]); wv4.y = cvtpk(o1[2], o1[3]); wv4.z = cvtpk(o1[4], o1[5]); wv4.w = cvtpk(o1[6], o1[7]);
            *(u32x4*)(C.OAB + m * DM + 512 + h * 128 + 8 * l16) = wv4; }
    }
}

__device__ __forceinline__ void phase_final(const Params& P, const Ctx& C) {
    const int gw = C.vcu * 8 + C.wave, NGW = C.G * 8;
    const float* gpo = P.in[I_GPOST];
    for (int m4 = gw; m4 < NTOK / 4; m4 += NGW) {
        const int m = m4 * 4, b = m >> 13;
        float rstd[4];
        { const f32x4* rp = (const f32x4*)(C.ROWSQ + (size_t)m * 16);
#pragma unroll
          for (int r = 0; r < 4; ++r) { const f32x4 a0 = rp[4 * r], a1 = rp[4 * r + 1], a2 = rp[4 * r + 2], a3 = rp[4 * r + 3]; const f32x4 sa = (a0 + a1) + (a2 + a3);
              rstd[r] = rsqrtf(((sa.x + sa.y) + (sa.z + sa.w)) * (1.f / DM) + RMS_EPS); } }
        const f32x4* xr = (const f32x4*)(P.in[I_X] + (size_t)m * DM) + C.lane; f32x4* zr = (f32x4*)(P.out + (size_t)m * DM) + C.lane;
        const bf16_t* zb = C.PROJ + 1024 + (size_t)m * NINP + C.lane * 4;
        f32x4 xv[16]; u32x2 zz[16];
#pragma unroll
        for (int j = 0; j < 16; ++j) { xv[j] = __builtin_nontemporal_load(xr + 64 * j); zz[j] = *(const u32x2*)(zb + (size_t)(j >> 2) * NINP + 256 * (j & 3)); }
#pragma unroll
        for (int j = 0; j < 4; ++j) { const int idx = (C.lane + 64 * j) * 4;
            const f32x4 g = *(const f32x4*)(gpo + idx), gt = *(const f32x4*)(C.MOD + b * 3072 + 2048 + idx); const f32x4 gg = g * gt;
#pragma unroll
            for (int r = 0; r < 4; ++r) { const u32x2 z = zz[4 * r + j]; const f32x4 zv = (f32x4){bf2f(z.x & 0xffffu), bf2f(z.x >> 16), bf2f(z.y & 0xffffu), bf2f(z.y >> 16)};
                __builtin_nontemporal_store(xv[4 * r + j] + gg * (zv * rstd[r]), zr + 256 * r + 64 * j); } }
    }
}


__device__ __forceinline__ void gsync(unsigned* bar, unsigned target, int tid) {
    asm volatile("s_waitcnt vmcnt(0)" ::: "memory");
    __syncthreads();
    if (tid == 0) {
        __builtin_amdgcn_fence(__ATOMIC_RELEASE, "agent"); asm volatile("s_waitcnt vmcnt(0)" ::: "memory");
        __hip_atomic_fetch_add(bar, 1u, __ATOMIC_RELAXED, __HIP_MEMORY_SCOPE_AGENT);
        while (__hip_atomic_load(bar, __ATOMIC_RELAXED, __HIP_MEMORY_SCOPE_AGENT) < target) __builtin_amdgcn_s_sleep(2);
        __builtin_amdgcn_fence(__ATOMIC_ACQUIRE, "agent"); asm volatile("s_waitcnt vmcnt(0)" ::: "memory");
    }
    __syncthreads();
}

#define LAS __attribute__((address_space(3)))
#define XB_TMO      128
#define XB_XCNT(j)  (256  + 64 * (j))
#define XB_XSUB(j)  (1280 + 64 * (j))
#define XB_XGEN(j)  (2304 + 64 * (j))
#define XB_TOP      3328
#define XB_TOPGEN   3392
#define XCD_BAR_WORDS 3456
#define XB_SPIN_CAP (1u << 18)

__device__ __forceinline__ unsigned xb_ld(unsigned* p)              { return __hip_atomic_load(p, __ATOMIC_RELAXED, __HIP_MEMORY_SCOPE_AGENT); }
__device__ __forceinline__ unsigned xb_add(unsigned* p, unsigned v) { return __hip_atomic_fetch_add(p, v, __ATOMIC_RELAXED, __HIP_MEMORY_SCOPE_AGENT); }
__device__ __forceinline__ unsigned xb_xcc_id() { return (unsigned)__builtin_amdgcn_s_getreg((3 << 11) | 20) & 0xFu; }
#define XB_SPIN(cond, bar) do { unsigned _sp = 0; while (cond) { __builtin_amdgcn_s_sleep(1); \
    if ((++_sp & 255u) == 0u) { if (xb_ld(&(bar)[XB_TMO])) break; if (_sp > XB_SPIN_CAP) { atomicAdd(&(bar)[XB_TMO], 1u); break; } } } } while (0)

struct XcdBarrier {
    unsigned* bar; unsigned x;
    volatile LAS unsigned* st;
};

__device__ __forceinline__ XcdBarrier xcd_barrier_post(unsigned* bar, volatile LAS unsigned* st, int tid) {
    XcdBarrier b; b.bar = bar; b.x = xb_xcc_id(); b.st = st;
    if (tid == 0) (void)xb_add(&bar[XB_XCNT(b.x)], 1u);
    return b;
}
__device__ __forceinline__ void xcd_barrier_complete(unsigned* bar, unsigned x, unsigned& nloc, unsigned& nx) {
    const unsigned G = gridDim.x * gridDim.y * gridDim.z;
    unsigned sum, cnt, mine, sp = 0u;
    for (;;) {
        sum = 0u; cnt = 0u; mine = 0u;
#pragma unroll
        for (unsigned j = 0; j < 16; ++j) { const unsigned c = xb_ld(&bar[XB_XCNT(j)]); sum += c; cnt += (c > 0u) ? 1u : 0u; mine = (j == x) ? c : mine; }
        if (sum == G) break;
        __builtin_amdgcn_s_sleep(1);
        if ((++sp & 255u) == 0u) { if (xb_ld(&bar[XB_TMO])) break; if (sp > XB_SPIN_CAP) { atomicAdd(&bar[XB_TMO], 1u); break; } }
    }
    nloc = mine > 0u ? mine : 1u; nx = cnt > 0u ? cnt : 1u;
}

__device__ __forceinline__ void xcd_barrier(const XcdBarrier& b, int tid) {
    asm volatile("s_waitcnt vmcnt(0)" ::: "memory");
    __syncthreads();
    if (tid == 0) {
        unsigned* bar = b.bar;
        __builtin_amdgcn_s_waitcnt(0);
        unsigned nloc = b.st[0], nx = b.st[1];
        if (nloc == 0u) { xcd_barrier_complete(bar, b.x, nloc, nx); b.st[0] = nloc; b.st[1] = nx; }
        const unsigned old = xb_add(&bar[XB_XSUB(b.x)], 1u);
        const unsigned gen = old / nloc;
        if (old + 1u == (gen + 1u) * nloc) {
            __builtin_amdgcn_fence(__ATOMIC_RELEASE, "agent");
            asm volatile("s_waitcnt vmcnt(0)" ::: "memory");
            const unsigned og = xb_add(&bar[XB_TOP], 1u);
            const unsigned tg = og / nx;
            if (og + 1u == (tg + 1u) * nx) xb_add(&bar[XB_TOPGEN], 1u);
            else XB_SPIN(xb_ld(&bar[XB_TOPGEN]) == tg, bar);
            __builtin_amdgcn_fence(__ATOMIC_ACQUIRE, "agent");
            xb_add(&bar[XB_XGEN(b.x)], 1u);
            asm volatile("s_waitcnt vmcnt(0)" ::: "memory");
        } else {
            XB_SPIN(xb_ld(&bar[XB_XGEN(b.x)]) == gen, bar);
            __builtin_amdgcn_fence(__ATOMIC_ACQUIRE, "agent");
            asm volatile("s_waitcnt vmcnt(0)" ::: "memory");
        }
    }
    __syncthreads();
}

__global__ void __launch_bounds__(NTHR, 2) fwd_kernel(Params P) {
    extern __shared__ __attribute__((aligned(16))) unsigned char lds[];
    cg::grid_group grid = cg::this_grid();
    Ctx C;
    C.lds = lds;
    C.G = gridDim.x; { const int bx = blockIdx.x; C.vcu = (C.G % 8 == 0) ? (bx % 8) * (C.G / 8) + bx / 8 : bx; }
    unsigned char* ws = P.ws;
    C.ROWSQ = (float*)(ws + WS_ROWSQ); C.MOD = (float*)(ws + WS_MOD);
    C.WIN = (bf16_t*)(ws + WS_WIN); C.WAB = (bf16_t*)(ws + WS_WAB); C.WOUT = (bf16_t*)(ws + WS_WOUT);
    C.XN = (bf16_t*)(ws + WS_XN); C.OAB = C.XN; C.PROJ = (bf16_t*)(ws + WS_PROJ);
    C.OARAW = P.out; C.OB4 = (bf16_t*)((unsigned char*)P.out + 128 * MiB);

    const int s_wave = __builtin_amdgcn_readfirstlane((int)threadIdx.x >> 6);
#define MY_TID() ({ int l_; asm volatile("v_mbcnt_lo_u32_b32 %0, -1, 0\n\tv_mbcnt_hi_u32_b32 %0, -1, %0" : "=v"(l_)); s_wave * 64 + l_; })
#define FRESH() do { int t_ = MY_TID(); asm volatile("" : "+v"(t_)); C.tid = t_; C.lane = t_ & 63; C.wave = s_wave; \
        unsigned char* w_ = P.ws; unsigned char* o_ = (unsigned char*)P.out; asm volatile("" : "+s"(w_), "+s"(o_));     \
        ws = w_; C.ROWSQ = (float*)(w_ + WS_ROWSQ); C.MOD = (float*)(w_ + WS_MOD); C.WIN = (bf16_t*)(w_ + WS_WIN); C.WAB = (bf16_t*)(w_ + WS_WAB); C.WOUT = (bf16_t*)(w_ + WS_WOUT); \
        C.XN = (bf16_t*)(w_ + WS_XN); C.OAB = C.XN; C.PROJ = (bf16_t*)(w_ + WS_PROJ); C.OARAW = (float*)o_; C.OB4 = (bf16_t*)(o_ + 128 * MiB); } while (0)
#ifdef PROBE_A
    unsigned long long* TS = (unsigned long long*)(ws + WS_QCTR + 1024);
#define STAMP(k) do { if (blockIdx.x == 0 && threadIdx.x == 0) TS[k] = __builtin_amdgcn_s_memrealtime(); } while (0)
#else
#define STAMP(k) do {} while (0)
#endif
    unsigned nbar = 0u;
#define GSYNC() xcd_barrier(xbar, C.tid)
    if (threadIdx.x < 2) ((volatile unsigned*)(lds + LDS_BYTES - 32))[threadIdx.x] = 0u;
    __syncthreads();
    FRESH();
    STAMP(0);
    if (blockIdx.x == 1) { for (int i = C.tid; i < 2048; i += NTHR) ((unsigned*)(ws + WS_QCTR))[i] = 0u; for (int i = C.tid; i < 3456; i += NTHR) ((unsigned*)(ws + WS_QCTR))[24576 + i] = 0u; }
    grid.sync(); FRESH();
    XcdBarrier xbar = xcd_barrier_post((unsigned*)(ws + WS_QCTR) + 24576, (volatile LAS unsigned*)((LAS unsigned char*)lds + LDS_BYTES - 32), C.tid);
    phase_prologue(P, C);
    GSYNC(); FRESH(); STAMP(1);
    phase_prenorm(P, C);
    GSYNC(); FRESH(); STAMP(2);
    { pg8::Gemm g{C.XN, C.WIN, NTOK, NIN, DM, DM, DM}; pg8::StaticOrder S; S.init(NTOK, NIN, C.G, (int)blockIdx.x); EpiProj2 E{C.PROJ, (bf16_t*)P.out, (bf16_t*)P.out + (size_t)32 * 1024 * 1024};
      pg8::gemm_phase<EpiProj2, pg8::StaticOrder, true, true>((PG8_LAS unsigned char*)lds, g, S, E, C.tid); }
    GSYNC(); FRESH(); STAMP(3);
    if (blockIdx.x < 32) hgrn_chain(P, C, (int)blockIdx.x >> 2, (int)blockIdx.x & 3);
    FRESH();
    phase_attn(C, (unsigned*)(ws + WS_QCTR));
    GSYNC(); FRESH(); STAMP(4);
    phase_branch_norm(P, C);
    GSYNC(); FRESH(); STAMP(5);
    { pg8::Gemm g{C.OAB, C.WAB, NTOK, DM, DM, DM, DM}; pg8::StaticOrder S; S.init(NTOK, DM, C.G, (int)blockIdx.x); EpiMerge2 E{C.PROJ, (bf16_t*)P.out};
      pg8::gemm_phase<EpiMerge2, pg8::StaticOrder, true, true>((PG8_LAS unsigned char*)lds, g, S, E, C.tid); }
    GSYNC(); FRESH(); STAMP(6);
    { pg8::Gemm g{(const bf16_t*)P.out, C.WOUT, NTOK, DM, DM, DM, DM}; pg8::StaticOrder S; S.init(NTOK, DM, C.G, (int)blockIdx.x); EpiZ2 E{C.PROJ + 1024, C.ROWSQ};
      pg8::gemm_phase<EpiZ2, pg8::StaticOrder, true, true>((PG8_LAS unsigned char*)lds, g, S, E, C.tid); }

    GSYNC(); FRESH();
    phase_final(P, C);
#ifdef PROBE_A
    { const float d2 = (float)(TS[PROBE_B + 1] - TS[PROBE_B]) * 1e-5f;
      for (int m = C.vcu * 8 + C.wave; m < NTOK; m += C.G * 8) { f32x4* zr = (f32x4*)(P.out + (size_t)m * DM) + C.lane;
          for (int j = 0; j < 4; ++j) zr[64 * j] = zr[64 * j] + d2; }
      GSYNC();
      if (blockIdx.x == 0 && threadIdx.x == 0) P.out[0] += (float)(TS[PROBE_A + 1] - TS[PROBE_A]) * 1e-4f; }
#endif
}

extern "C" void kernel_launch(void* const* d_in, const int* in_sizes, int n_in, void* d_out, int out_size, void* d_ws, size_t ws_size, hipStream_t stream) {
    static int grid = 0;
    if (grid == 0) {
        if (n_in != 17 || out_size != NTOK * DM || ws_size < WS_END) { fprintf(stderr, "kernel_launch: unexpected shapes (n_in %d out %d ws %zu)\n", n_in, out_size, ws_size); grid = -1; return; }
        int dev = 0, cus = 0, per_cu = 0;
        hipGetDevice(&dev); hipDeviceGetAttribute(&cus, hipDeviceAttributeMultiprocessorCount, dev);
        hipFuncSetAttribute((const void*)fwd_kernel, hipFuncAttributeMaxDynamicSharedMemorySize, LDS_BYTES);
        hipOccupancyMaxActiveBlocksPerMultiprocessor(&per_cu, (const void*)fwd_kernel, NTHR, LDS_BYTES);
        if (per_cu < 1) { fprintf(stderr, "kernel_launch: occupancy query says %d blocks per CU\n", per_cu); per_cu = 1; }
        grid = cus * 1; if (grid < 32) { fprintf(stderr, "kernel_launch: needs at least 32 CUs\n"); grid = -1; return; }
        (void)hipGetLastError();
    }
    if (grid < 0) return;
    Params p{};
    for (int i = 0; i < 17; ++i) p.in[i] = (const float*)d_in[i];
    p.out = (float*)d_out; p.ws = (unsigned char*)d_ws;
    void* args[] = {&p};
    hipError_t e = hipLaunchCooperativeKernel((const void*)fwd_kernel, dim3(grid), dim3(NTHR), args, LDS_BYTES, stream);
    if (e != hipSuccess) fprintf(stderr, "cooperative launch failed: %s (grid %d)\n", hipGetErrorString(e), grid);
}
```
